# Optimizing an MI355X kernel written in HIP

```python
import jax, jax.numpy as jnp
from jax import lax
import numpy as np

D_MODEL = 1024
BATCH = 4
SEQ = 4096
DEPTH = 1

CHUNK = 64
LEFT_CHUNKS = 8
BAND = (LEFT_CHUNKS + 1) * CHUNK
ATT_HEADS = 8
ATT_HEAD_DIM = 64
ATT_WIDTH = ATT_HEADS * ATT_HEAD_DIM
MAX_REL = 128
LRU_WIDTH = D_MODEL
LRU_BLOCKS = 16
LRU_BLOCK = LRU_WIDTH // LRU_BLOCKS
CONV_WIDTH = 4
LRU_C = 8.0
D_FF = 2816
N_SUB = 3
EPS = 1e-6
PROJ_SIZES = (ATT_WIDTH, ATT_WIDTH, ATT_WIDTH, LRU_WIDTH, LRU_WIDTH, D_MODEL, D_MODEL)
PROJ_WIDTH = sum(PROJ_SIZES)

kernel_name = "hybrid_chunked_attn_rglru_macaron_block"


def rmsnorm(x, g):
    xf = x.astype(jnp.float32)
    y = xf * lax.rsqrt(jnp.mean(xf * xf, axis=-1, keepdims=True) + EPS)
    return (y * g.astype(jnp.float32)).astype(x.dtype)


def modulate(h, shift, scale):
    return h * (1 + scale[:, None, :]) + shift[:, None, :]


def swiglu(h, w_gu, w_down):
    g, u = jnp.split(h @ w_gu, 2, axis=-1)
    return (jax.nn.silu(g) * u) @ w_down


def chunked_attention(q, k, v, rel_bias):
    b, s, _ = q.shape
    nc = s // CHUNK
    q = q.reshape(b, nc, CHUNK, ATT_HEADS, ATT_HEAD_DIM)
    k = k.reshape(b, nc, CHUNK, ATT_HEADS, ATT_HEAD_DIM)
    v = v.reshape(b, nc, CHUNK, ATT_HEADS, ATT_HEAD_DIM)
    pad = ((0, 0), (LEFT_CHUNKS, 0), (0, 0), (0, 0), (0, 0))
    kp, vp = jnp.pad(k, pad), jnp.pad(v, pad)
    kb = jnp.concatenate([kp[:, j:j + nc] for j in range(LEFT_CHUNKS + 1)], axis=2)
    vb = jnp.concatenate([vp[:, j:j + nc] for j in range(LEFT_CHUNKS + 1)], axis=2)
    scores = jnp.einsum('bnqhd,bnkhd->bhnqk', q, kb).astype(jnp.float32) * (ATT_HEAD_DIM ** -0.5)
    qi = jnp.arange(CHUNK)[:, None]
    kj = jnp.arange(BAND)[None, :]
    rel = jnp.clip(qi - kj + LEFT_CHUNKS * CHUNK, -MAX_REL, MAX_REL) + MAX_REL
    bias = rel_bias.astype(jnp.float32)[:, rel]
    scores = scores + bias[None, :, None, :, :]
    valid = (jnp.arange(nc)[:, None] - LEFT_CHUNKS + jnp.arange(BAND)[None, :] // CHUNK) >= 0
    scores = jnp.where(valid[None, None, :, None, :], scores, jnp.finfo(jnp.float32).min)
    p = jax.nn.softmax(scores, axis=-1).astype(v.dtype)
    out = jnp.einsum('bhnqk,bnkhd->bnqhd', p, vb)
    return out.reshape(b, s, ATT_WIDTH)


def causal_depthwise_conv(x, w, bias):
    rhs = w[:, None, :]
    y = lax.conv_general_dilated(x, rhs, window_strides=(1,), padding=[(CONV_WIDTH - 1, 0)],
                                 dimension_numbers=('NWC', 'WIO', 'NWC'),
                                 feature_group_count=x.shape[-1])
    return y + bias


def block_diag_linear(x, w, bias):
    b, s, _ = x.shape
    xb = x.reshape(b, s, LRU_BLOCKS, LRU_BLOCK)
    return jnp.einsum('bsnk,nkj->bsnj', xb, w).reshape(b, s, LRU_WIDTH) + bias


def rg_lru(x, w_a, b_a, w_x, b_x, lam):
    r = jax.nn.sigmoid(block_diag_linear(x, w_a, b_a).astype(jnp.float32))
    i = jax.nn.sigmoid(block_diag_linear(x, w_x, b_x).astype(jnp.float32))
    log_a = -LRU_C * r * jax.nn.softplus(-lam.astype(jnp.float32))
    a = jnp.exp(log_a)
    mult = jnp.sqrt(-jnp.expm1(2.0 * log_a))
    u = mult * (i * x.astype(jnp.float32))

    def combine(left, right):
        a1, b1 = left
        a2, b2 = right
        return a1 * a2, a2 * b1 + b2

    _, h = lax.associative_scan(combine, (a, u), axis=1)
    return h.astype(x.dtype)


def mixer(h, w_in, rel_bias, conv_w, conv_b, lru_wa, lru_ba, lru_wx, lru_bx, lru_lambda,
          w_att_o, w_rec_o, w_out):
    proj = h @ w_in
    idx = [int(v) for v in np.cumsum(PROJ_SIZES)[:-1]]
    q, k, v, xr, yr, g_att, g_rec = jnp.split(proj, idx, axis=-1)
    att = chunked_attention(q, k, v, rel_bias) @ w_att_o
    xr = causal_depthwise_conv(xr, conv_w, conv_b)
    rec = (rg_lru(xr, lru_wa, lru_ba, lru_wx, lru_bx, lru_lambda) * jax.nn.gelu(yr)) @ w_rec_o
    merged = jax.nn.sigmoid(g_att) * att + jax.nn.sigmoid(g_rec) * rec
    return merged @ w_out


def sandwich(x, fn, g_pre, g_post, shift, scale, gate, res_w):
    h = modulate(rmsnorm(x, g_pre), shift, scale)
    y = rmsnorm(fn(h), g_post)
    return x + res_w * gate[:, None, :] * y


def setup_inputs(seed: int = 0) -> dict:
    key = jax.random.key(seed)
    ks = jax.random.split(key, 24)
    L, D, F, W = DEPTH, D_MODEL, D_FF, LRU_WIDTH
    nrm = lambda k, shape, fan_in: jax.random.normal(k, shape, jnp.float32) * (fan_in ** -0.5)
    u = jax.random.uniform(ks[20], (L, W), jnp.float32, 0.9, 0.999)
    p = u ** (1.0 / LRU_C)
    lam = jnp.log(p) - jnp.log1p(-p)
    return {
        "x": jax.random.normal(ks[0], (BATCH, SEQ, D), jnp.float32),
        "c": jax.random.normal(ks[1], (BATCH, D), jnp.float32),
        "w_ada": nrm(ks[2], (L, D, N_SUB * 3 * D), D) * 0.5,
        "b_ada": 0.02 * jax.random.normal(ks[3], (L, N_SUB * 3 * D), jnp.float32),
        "norm_pre": 1.0 + 0.05 * jax.random.normal(ks[4], (L, N_SUB, D), jnp.float32),
        "norm_post": 1.0 + 0.05 * jax.random.normal(ks[5], (L, N_SUB, D), jnp.float32),
        "ffn1_w_gu": nrm(ks[6], (L, D, 2 * F), D),
        "ffn1_w_down": nrm(ks[7], (L, F, D), F),
        "w_in": nrm(ks[8], (L, D, PROJ_WIDTH), D),
        "rel_bias": 0.5 * jax.random.normal(ks[9], (L, ATT_HEADS, 2 * MAX_REL + 1), jnp.float32),
        "conv_w": nrm(ks[10], (L, CONV_WIDTH, W), CONV_WIDTH),
        "conv_b": 0.02 * jax.random.normal(ks[11], (L, W), jnp.float32),
        "lru_wa": nrm(ks[12], (L, LRU_BLOCKS, LRU_BLOCK, LRU_BLOCK), LRU_BLOCK),
        "lru_ba": 0.02 * jax.random.normal(ks[13], (L, W), jnp.float32),
        "lru_wx": nrm(ks[14], (L, LRU_BLOCKS, LRU_BLOCK, LRU_BLOCK), LRU_BLOCK),
        "lru_bx": 0.02 * jax.random.normal(ks[15], (L, W), jnp.float32),
        "lru_lambda": lam,
        "w_att_o": nrm(ks[16], (L, ATT_WIDTH, D), ATT_WIDTH),
        "w_rec_o": nrm(ks[17], (L, W, D), W),
        "w_out": nrm(ks[18], (L, D, D), D),
        "ffn2_w_gu": nrm(ks[19], (L, D, 2 * F), D),
        "ffn2_w_down": nrm(ks[21], (L, F, D), F),
    }


def reference(x, c, w_ada, b_ada, norm_pre, norm_post, ffn1_w_gu, ffn1_w_down, w_in, rel_bias,
              conv_w, conv_b, lru_wa, lru_ba, lru_wx, lru_bx, lru_lambda, w_att_o, w_rec_o,
              w_out, ffn2_w_gu, ffn2_w_down):
    b = x.shape[0]
    c_act = jax.nn.silu(c)
    for l in range(DEPTH):
        mod = (c_act @ w_ada[l] + b_ada[l]).reshape(b, N_SUB, 3, D_MODEL)
        ffn1 = lambda h: swiglu(h, ffn1_w_gu[l], ffn1_w_down[l])
        mix = lambda h: mixer(h, w_in[l], rel_bias[l], conv_w[l], conv_b[l], lru_wa[l], lru_ba[l],
                              lru_wx[l], lru_bx[l], lru_lambda[l], w_att_o[l], w_rec_o[l], w_out[l])
        ffn2 = lambda h: swiglu(h, ffn2_w_gu[l], ffn2_w_down[l])
        x = sandwich(x, ffn1, norm_pre[l, 0], norm_post[l, 0], mod[:, 0, 0], mod[:, 0, 1], mod[:, 0, 2], 0.5)
        x = sandwich(x, mix, norm_pre[l, 1], norm_post[l, 1], mod[:, 1, 0], mod[:, 1, 1], mod[:, 1, 2], 1.0)
        x = sandwich(x, ffn2, norm_pre[l, 2], norm_post[l, 2], mod[:, 2, 0], mod[:, 2, 1], mod[:, 2, 2], 0.5)
    return x
```

```cpp
#include <hip/hip_runtime.h>
#include <hip/hip_cooperative_groups.h>
#include <cstdio>
#include <cstdint>
namespace cg = cooperative_groups;
#ifndef MK_MULTI
#define MK_MULTI 0
#endif
namespace pg8 {
#define PG8_LAS __attribute__((address_space(3)))
typedef unsigned short bf16_t;
typedef short bf16x8 __attribute__((ext_vector_type(8)));
typedef float f32x4 __attribute__((ext_vector_type(4)));
typedef unsigned u32x4 __attribute__((ext_vector_type(4)));
constexpr int BM = 256, BK = 64, HALF = 128, HTB = HALF * BK * 2  , STAGE_BYTES = 8 * HTB, NXCD = 8, WGM = 8;

__host__ __device__ __forceinline__ int lds_byte(int r, int c) { const int st = (r >> 4) * 2 + (c >> 5), rr = r & 15, cc = c & 31, ob = rr * 64 + cc * 2; return st * 1024 + (ob ^ (((ob >> 9) & 1) << 5)); }
__host__ __device__ __forceinline__ void stage_rc(int b, int& R, int& C) { const int st = b / 1024, sb = b % 1024, swz = sb ^ (((sb >> 9) & 1) << 5); R = (st >> 1) * 16 + swz / 64; C = (st & 1) * 32 + (swz % 64) / 2; }
__host__ __device__ __forceinline__ int perm32(int rho) { const int n = rho >> 4, i = rho & 15; return 8 * (i >> 2) + 4 * n + (i & 3); }

struct Unit { int pm, pn; };
struct Gemm { const bf16_t* A; const bf16_t* Bt; int M, N, K; };

struct StaticOrder {
    int nM, nN, nwg, G, c;
    __host__ __device__ void init(int M, int N, int G_, int c_) { nM = M / BM; nN = N / BM; nwg = nM * nN; G = G_; c = c_; }
    __host__ __device__ bool next(int i, Unit& u) const {
        const long L = (long)i * G + c; if (L >= nwg) return false;
        int wgid = (int)L; { const int q = nwg / NXCD, r = nwg % NXCD, xcd = wgid % NXCD, off = wgid / NXCD; wgid = (xcd < r ? xcd * (q + 1) : r * (q + 1) + (xcd - r) * q) + off; }
        const int nig = WGM * nN, gid = wgid / nig, fm = gid * WGM, gsz = (nM - fm) < WGM ? (nM - fm) : WGM;
        u.pm = fm + ((wgid % nig) % gsz); u.pn = (wgid % nig) / gsz; return true;
    }
    __device__ __forceinline__ void a_ready(const Unit&) const {}
    __device__ __forceinline__ void done(const Unit&) const {}
};

__device__ __forceinline__ unsigned cvt_pk_bf16(float lo, float hi) { unsigned r; asm volatile("v_cvt_pk_bf16_f32 %0, %1, %2" : "=v"(r) : "v"(lo), "v"(hi)); return r; }
typedef float f32x2 __attribute__((ext_vector_type(2)));
typedef unsigned u32x2 __attribute__((ext_vector_type(2)));
__device__ __forceinline__ float fsig(float x) { return __builtin_amdgcn_rcpf(1.f + __builtin_amdgcn_exp2f(-1.4426950408889634f * x)); }
__device__ __forceinline__ float bflo(unsigned w) { return __uint_as_float(w << 16); }
__device__ __forceinline__ float bfhi(unsigned w) { return __uint_as_float(w & 0xffff0000u); }
__device__ __forceinline__ u32x4 pack8(const float* o) { u32x4 w; w.x = cvt_pk_bf16(o[0], o[1]); w.y = cvt_pk_bf16(o[2], o[3]); w.z = cvt_pk_bf16(o[4], o[5]); w.w = cvt_pk_bf16(o[6], o[7]); return w; }

struct EpiSwiglu {
    static constexpr bool PERM = true, AFTER_DRAIN = false;
    bf16_t* O; int ldc;
    __device__ __forceinline__ void operator()(const f32x4 (&acc)[2][2][4][2], const Unit& u, int wr, int wc, int fr, int fq) const {
        const int row0 = u.pm * BM + wr * 64 + fr, col0 = u.pn * HALF + wc * 32 + 8 * fq;
#pragma unroll
        for (int ai = 0; ai < 2; ++ai)
#pragma unroll
            for (int m = 0; m < 4; ++m) {
                float o[8];
#pragma unroll
                for (int n = 0; n < 2; ++n)
#pragma unroll
                    for (int e = 0; e < 4; ++e) { const float g = acc[ai][0][m][n][e], uu = acc[ai][1][m][n][e]; o[n * 4 + e] = g * fsig(g) * uu; }
                *(u32x4*)(O + (size_t)(row0 + ai * HALF + m * 16) * ldc + col0) = pack8(o);
            }
    }
};
struct EpiY {
    static constexpr bool PERM = true, AFTER_DRAIN = false;
    bf16_t* Y; float* ssq;
    __device__ __forceinline__ void operator()(const f32x4 (&acc)[2][2][4][2], const Unit& u, int wr, int wc, int fr, int fq) const {
        const int row0 = u.pm * BM + wr * 64 + fr, col0 = u.pn * BM + wc * 32 + 8 * fq;
#pragma unroll
        for (int ai = 0; ai < 2; ++ai)
#pragma unroll
            for (int m = 0; m < 4; ++m) {
                const int row = row0 + ai * HALF + m * 16; float s = 0.f;
#pragma unroll
                for (int bj = 0; bj < 2; ++bj) {
                    float o[8];
#pragma unroll
                    for (int n = 0; n < 2; ++n)
#pragma unroll
                        for (int e = 0; e < 4; ++e) { const float v = acc[ai][bj][m][n][e]; o[n * 4 + e] = v; s += v * v; }
                    *(u32x4*)(Y + (size_t)row * 1024 + col0 + bj * HALF) = pack8(o);
                }
                s += __shfl_xor(s, 16); s += __shfl_xor(s, 32);
                if (fq == 0) ssq[(size_t)row * 16 + u.pn * 4 + wc] = s;
            }
    }
};
struct EpiProj {
    static constexpr bool PERM = true, AFTER_DRAIN = false;
    bf16_t *Q, *K, *Vt, *XR, *GY, *SGA, *SGR; float qscale;
    __device__ __forceinline__ void operator()(const f32x4 (&acc)[2][2][4][2], const Unit& u, int wr, int wc, int fr, int fq) const {
        const int pn = u.pn, row0 = u.pm * BM + wr * 64 + fr;
        if (pn >= 4 && pn < 6) {
            const int cbase = (pn - 4) * 256 + wc * 32 + 8 * fq;
#pragma unroll
            for (int ai = 0; ai < 2; ++ai)
#pragma unroll
                for (int m = 0; m < 4; ++m) {
                    const int row = row0 + ai * HALF + m * 16, b = row >> 12, s = row & 4095;
#pragma unroll
                    for (int bj = 0; bj < 2; ++bj)
#pragma unroll
                        for (int n = 0; n < 2; ++n) {
                            const f32x4 v = acc[ai][bj][m][n]; const unsigned w0 = cvt_pk_bf16(v[0], v[1]), w1 = cvt_pk_bf16(v[2], v[3]);
                            bf16_t* p = Vt + (((size_t)(b * 512 + cbase + bj * HALF + 4 * n)) << 12) + s;
                            p[0] = (bf16_t)(w0 & 0xffffu); p[4096] = (bf16_t)(w0 >> 16); p[8192] = (bf16_t)(w1 & 0xffffu); p[12288] = (bf16_t)(w1 >> 16);
                        }
                }
            return;
        }
        bf16_t* base; int ld, ct, mode;
        if (pn < 2) { base = Q; ld = 512; ct = pn; mode = 0; }
        else if (pn < 4) { base = K; ld = 512; ct = pn - 2; mode = 1; }
        else if (pn < 10) { base = XR; ld = 1024; ct = pn - 6; mode = 1; }
        else if (pn < 14) { base = GY; ld = 1024; ct = pn - 10; mode = 2; }
        else if (pn < 18) { base = SGA; ld = 1024; ct = pn - 14; mode = 3; }
        else { base = SGR; ld = 1024; ct = pn - 18; mode = 3; }
        const int col0 = ct * 256 + wc * 32 + 8 * fq;
#pragma unroll
        for (int ai = 0; ai < 2; ++ai)
#pragma unroll
            for (int m = 0; m < 4; ++m) {
                bf16_t* rowp = base + (size_t)(row0 + ai * HALF + m * 16) * ld + col0;
#pragma unroll
                for (int bj = 0; bj < 2; ++bj) {
                    float o[8];
#pragma unroll
                    for (int n = 0; n < 2; ++n)
#pragma unroll
                        for (int e = 0; e < 4; ++e) {
                            float v = acc[ai][bj][m][n][e];
                            if (mode == 0) v *= qscale;
                            else if (mode == 2) { const float z = 1.5957691216057308f * (v + 0.044715f * v * v * v); v = v * fsig(z); }
                            else if (mode == 3) v = fsig(v);
                            o[n * 4 + e] = v;
                        }
                    *(u32x4*)(rowp + bj * HALF) = pack8(o);
                }
            }
    }
};
template <bool ADD> struct EpiGate {
    static constexpr bool PERM = true, AFTER_DRAIN = false;
    const bf16_t* gate; bf16_t* mg;
    __device__ __forceinline__ void operator()(const f32x4 (&acc)[2][2][4][2], const Unit& u, int wr, int wc, int fr, int fq) const {
        const int row0 = u.pm * BM + wr * 64 + fr, col0 = u.pn * BM + wc * 32 + 8 * fq;
#pragma unroll
        for (int ai = 0; ai < 2; ++ai)
#pragma unroll
            for (int m = 0; m < 4; ++m)
#pragma unroll
                for (int bj = 0; bj < 2; ++bj) {
                    const size_t off = (size_t)(row0 + ai * HALF + m * 16) * 1024 + col0 + bj * HALF;
                    const u32x4 g = *(const u32x4*)(gate + off); u32x4 a = (u32x4){0u, 0u, 0u, 0u}; if (ADD) a = *(const u32x4*)(mg + off);
                    float o[8];
#pragma unroll
                    for (int n = 0; n < 2; ++n) { const f32x4 v = acc[ai][bj][m][n]; const unsigned g0 = n ? g.z : g.x, g1 = n ? g.w : g.y, a0 = n ? a.z : a.x, a1 = n ? a.w : a.y;
                        o[n * 4 + 0] = bflo(g0) * v[0]; o[n * 4 + 1] = bfhi(g0) * v[1]; o[n * 4 + 2] = bflo(g1) * v[2]; o[n * 4 + 3] = bfhi(g1) * v[3];
                        if (ADD) { o[n * 4 + 0] += bflo(a0); o[n * 4 + 1] += bfhi(a0); o[n * 4 + 2] += bflo(a1); o[n * 4 + 3] += bfhi(a1); } }
                    *(u32x4*)(mg + off) = pack8(o);
                }
    }
};

template <class Epi, class Sched, bool ALIGN_EPI = false, bool SP2 = false>
__device__ __forceinline__ void gemm_phase(PG8_LAS unsigned char* lds, const Gemm g, const Sched& S, const Epi& E) {
    const int tid = threadIdx.x, wid = __builtin_amdgcn_readfirstlane(tid >> 6), lane = tid & 63, wr = wid >> 2, wc = wid & 3, fr = lane & 15, fq = lane >> 4;
    const int K = g.K, nt = K / BK;
    unsigned voffA[2], voffB[2];
#pragma unroll
    for (int i = 0; i < 2; ++i) { int R, C; stage_rc(tid * 16 + i * 8192, R, C); const int Rb = Epi::PERM ? ((R & ~31) + perm32(R & 31)) : R;
        voffA[i] = (unsigned)(R * K + C) * 2u; voffB[i] = (unsigned)(Rb * K + C) * 2u; }
    const size_t kstep = (size_t)(BK * 2);
    const size_t hstep = (size_t)HALF * K * 2;
    const size_t tstep = 2 * hstep;
    const unsigned ldsw = (unsigned)wid * 1024u;
    const int aoff = lds_byte(wr * 64 + fr, fq * 8), boff = lds_byte(wc * 32 + fr, fq * 8);
#define PG8_SA(b, h) (((b) * 2 + (h)) * HTB)
#define PG8_SB(b, h) ((4 + (b) * 2 + (h)) * HTB)
#define PG8_STAGE(bufoff, gbase, voff) do { _Pragma("unroll") for (int _i = 0; _i < 2; ++_i) \
        __builtin_amdgcn_global_load_lds((const unsigned*)((const char*)(gbase) + (voff)[_i]), (PG8_LAS unsigned*)(lds + (bufoff) + ldsw + _i * 8192), 16, 0, 0); } while (0)
#define PG8_LDA(dst, b, h) do { _Pragma("unroll") for (int m = 0; m < 4; ++m) _Pragma("unroll") for (int k = 0; k < 2; ++k) dst[m][k] = *(const PG8_LAS bf16x8*)(lds + PG8_SA(b, h) + aoff + m * 2048 + k * 1024); } while (0)
#define PG8_LDB(dst, b, h) do { _Pragma("unroll") for (int n = 0; n < 2; ++n) _Pragma("unroll") for (int k = 0; k < 2; ++k) dst[n][k] = *(const PG8_LAS bf16x8*)(lds + PG8_SB(b, h) + boff + n * 2048 + k * 1024); } while (0)
#define PG8_MMA(ai, bj, At, Bt) do { __builtin_amdgcn_s_setprio(1); _Pragma("unroll") for (int m = 0; m < 4; ++m) _Pragma("unroll") for (int n = 0; n < 2; ++n) _Pragma("unroll") for (int k = 0; k < 2; ++k) \
        acc[ai][bj][m][n] = __builtin_amdgcn_mfma_f32_16x16x32_bf16(Bt[n][k], At[m][k], acc[ai][bj][m][n], 0, 0, 0); __builtin_amdgcn_s_setprio(0); } while (0)
#define PG8_WAIT_V(n) asm volatile("s_waitcnt vmcnt(" #n ")" ::: "memory")
#define PG8_WAIT_L(n) asm volatile("s_waitcnt lgkmcnt(" #n ")" ::: "memory")
#define PG8_BAR __builtin_amdgcn_s_barrier()
#define PG8_SCHED __builtin_amdgcn_sched_barrier(0)
    Unit cur, nxt; int ui = 0;
    if (!S.next(0, cur)) return;
    f32x4 acc[2][2][4][2];
#pragma unroll
    for (int a = 0; a < 2; ++a)
#pragma unroll
        for (int b = 0; b < 2; ++b)
#pragma unroll
            for (int m = 0; m < 4; ++m)
#pragma unroll
                for (int n = 0; n < 2; ++n) acc[a][b][m][n] = (f32x4){0.f, 0.f, 0.f, 0.f};
    bf16x8 At[4][2], B0[2][2], B1[2][2];
    const char* cA = (const char*)g.A + (size_t)cur.pm * tstep; const char* cB = (const char*)g.Bt + (size_t)cur.pn * tstep;
    S.a_ready(cur);
    if constexpr (SP2) {
        PG8_STAGE(PG8_SB(0, 0), cB, voffB); PG8_STAGE(PG8_SB(0, 1), cB + hstep, voffB); PG8_STAGE(PG8_SA(0, 0), cA, voffA); PG8_STAGE(PG8_SA(0, 1), cA + hstep, voffA);
        if (wr == 1) PG8_BAR;
        PG8_WAIT_V(2); PG8_BAR;
        PG8_STAGE(PG8_SB(1, 0), cB + kstep, voffB); PG8_STAGE(PG8_SA(1, 0), cA + kstep, voffA); PG8_STAGE(PG8_SB(1, 1), cB + hstep + kstep, voffB);
        PG8_WAIT_V(6); PG8_BAR;
    } else {
        PG8_STAGE(PG8_SB(0, 0), cB, voffB); PG8_STAGE(PG8_SA(0, 0), cA, voffA); PG8_STAGE(PG8_SB(0, 1), cB + hstep, voffB); PG8_STAGE(PG8_SA(0, 1), cA + hstep, voffA);
        if (wr == 1) PG8_BAR;
        PG8_WAIT_V(4); PG8_BAR;
        PG8_STAGE(PG8_SB(1, 0), cB + kstep, voffB); PG8_STAGE(PG8_SA(1, 0), cA + kstep, voffA); PG8_STAGE(PG8_SB(1, 1), cB + hstep + kstep, voffB);
        PG8_WAIT_V(6); PG8_BAR;
    }
    for (;;) {
        const bool has_next = S.next(ui + 1, nxt);
        const char* nA = has_next ? (const char*)g.A + (size_t)nxt.pm * tstep : cA; const char* nB = has_next ? (const char*)g.Bt + (size_t)nxt.pn * tstep : cB;
        for (int t = 0; t < nt; t += 2) {
            const bool last = (t == nt - 2);
            const char* a1 = cA + (size_t)(t + 1) * kstep;
            const char* a2 = last ? nA : cA + (size_t)(t + 2) * kstep; const char* b2 = last ? nB : cB + (size_t)(t + 2) * kstep;
            const char* a3 = a2 + kstep; const char* b3 = b2 + kstep;
            if (last && has_next) S.a_ready(nxt);
            if constexpr (SP2) {
            PG8_LDB(B0, 0, 0); PG8_LDB(B1, 0, 1); PG8_SCHED; PG8_LDA(At, 0, 0); PG8_STAGE(PG8_SA(1, 1), a1 + hstep, voffA);
            PG8_WAIT_V(8); PG8_WAIT_L(0); PG8_BAR; PG8_MMA(0, 0, At, B0); PG8_MMA(0, 1, At, B1); PG8_BAR; PG8_SCHED;
            PG8_LDA(At, 0, 1); PG8_STAGE(PG8_SB(0, 0), b2, voffB); PG8_STAGE(PG8_SB(0, 1), b2 + hstep, voffB); PG8_STAGE(PG8_SA(0, 0), a2, voffA);
            PG8_WAIT_V(8); PG8_WAIT_L(0); PG8_BAR; PG8_MMA(1, 0, At, B0); PG8_MMA(1, 1, At, B1); PG8_BAR; PG8_SCHED;
            PG8_LDB(B0, 1, 0); PG8_LDB(B1, 1, 1); PG8_SCHED; PG8_LDA(At, 1, 0); PG8_STAGE(PG8_SA(0, 1), a2 + hstep, voffA);
            PG8_WAIT_V(8); PG8_WAIT_L(0); PG8_BAR; PG8_MMA(0, 0, At, B0); PG8_MMA(0, 1, At, B1); PG8_BAR; PG8_SCHED;
            PG8_LDA(At, 1, 1); PG8_STAGE(PG8_SB(1, 0), b3, voffB); PG8_STAGE(PG8_SB(1, 1), b3 + hstep, voffB); PG8_STAGE(PG8_SA(1, 0), a3, voffA);
            PG8_WAIT_V(8); PG8_WAIT_L(0); PG8_BAR; PG8_MMA(1, 0, At, B0); PG8_MMA(1, 1, At, B1); PG8_BAR; PG8_SCHED;
            } else {
            PG8_LDB(B0, 0, 0); PG8_SCHED; PG8_LDA(At, 0, 0); PG8_STAGE(PG8_SA(1, 1), a1 + hstep, voffA);
            PG8_WAIT_L(8); PG8_BAR; PG8_WAIT_L(0); PG8_MMA(0, 0, At, B0); PG8_BAR; PG8_SCHED;
            PG8_LDB(B1, 0, 1); PG8_STAGE(PG8_SB(0, 0), b2, voffB);
            PG8_BAR; PG8_WAIT_L(0); PG8_MMA(0, 1, At, B1); PG8_BAR;
            PG8_LDA(At, 0, 1); PG8_STAGE(PG8_SA(0, 0), a2, voffA);
            PG8_BAR; PG8_WAIT_L(0); PG8_MMA(1, 0, At, B0); PG8_BAR; PG8_SCHED;
            PG8_STAGE(PG8_SB(0, 1), b2 + hstep, voffB);
            PG8_WAIT_V(6); PG8_BAR; PG8_MMA(1, 1, At, B1); PG8_BAR;
            PG8_LDB(B0, 1, 0); PG8_SCHED; PG8_LDA(At, 1, 0); PG8_STAGE(PG8_SA(0, 1), a2 + hstep, voffA);
            PG8_WAIT_L(8); PG8_BAR; PG8_WAIT_L(0); PG8_MMA(0, 0, At, B0); PG8_BAR; PG8_SCHED;
            PG8_LDB(B1, 1, 1); PG8_STAGE(PG8_SB(1, 0), b3, voffB);
            PG8_BAR; PG8_WAIT_L(0); PG8_MMA(0, 1, At, B1); PG8_BAR;
            PG8_LDA(At, 1, 1); PG8_STAGE(PG8_SA(1, 0), a3, voffA);
            PG8_BAR; PG8_WAIT_L(0); PG8_MMA(1, 0, At, B0); PG8_BAR; PG8_SCHED;
            PG8_STAGE(PG8_SB(1, 1), b3 + hstep, voffB);
            PG8_WAIT_V(6); PG8_BAR; PG8_MMA(1, 1, At, B1); PG8_BAR;
            }
        }
        if constexpr (ALIGN_EPI) { if (wr == 0) PG8_BAR; }
        if constexpr (!Epi::AFTER_DRAIN) { E(acc, cur, wr, wc, fr, fq); S.done(cur); }
        if (!has_next) break;
#pragma unroll
        for (int a = 0; a < 2; ++a)
#pragma unroll
            for (int b = 0; b < 2; ++b)
#pragma unroll
                for (int m = 0; m < 4; ++m)
#pragma unroll
                    for (int n = 0; n < 2; ++n) acc[a][b][m][n] = (f32x4){0.f, 0.f, 0.f, 0.f};
        cur = nxt; cA = nA; cB = nB; ++ui;
        if constexpr (ALIGN_EPI) { if (wr == 1) PG8_BAR; }
    }
    PG8_WAIT_V(0);
    if constexpr (!ALIGN_EPI) { if (wr == 0) PG8_BAR; }
    PG8_BAR;
    if constexpr (Epi::AFTER_DRAIN) { E.fused(acc, cur, wr, wc, fr, fq, lds, wid, lane); S.done(cur); }
#undef PG8_SA
#undef PG8_SB
#undef PG8_STAGE
#undef PG8_LDA
#undef PG8_LDB
#undef PG8_MMA
#undef PG8_WAIT_V
#undef PG8_WAIT_L
#undef PG8_BAR
#undef PG8_SCHED
}
}
#define LAS __attribute__((address_space(3)))
typedef unsigned short bf16_t;
typedef short bf16x8 __attribute__((ext_vector_type(8)));
typedef float f32x4 __attribute__((ext_vector_type(4)));
typedef float f32x16 __attribute__((ext_vector_type(16)));
typedef unsigned u32x4 __attribute__((ext_vector_type(4)));
typedef unsigned u32x2 __attribute__((ext_vector_type(2)));

constexpr int M = 16384, D = 1024, FF = 2816, SEQ = 4096, NB = 4, NPROJ = 5632;
constexpr float EPS = 1e-6f, LOG2E = 1.4426950408889634f;
constexpr int NWAVES = 8, NTHREADS = 512, LDS_BYTES = 132096;
constexpr int N_PHASES = 14;
constexpr size_t MiB = 1u << 20;
constexpr size_t WS_MOD = 0;
constexpr size_t WS_BIAS = 256 * 1024;
constexpr size_t WS_LRUWA = 512 * 1024, WS_LRUWX = 640 * 1024;
constexpr size_t WS_SSQ = 1 * MiB;
constexpr size_t WS_SUMA = 2 * MiB, WS_SUMH = 3 * MiB;
constexpr size_t WS_WIN = 4 * MiB, WS_WAO = 15 * MiB, WS_WRO = 16 * MiB, WS_WOUT = 18 * MiB, WS_WGU2 = 20 * MiB, WS_WD2 = 31 * MiB;
constexpr size_t WS_HB = 38 * MiB;
constexpr size_t WS_Z = 70 * MiB;
constexpr size_t WS_ACT = WS_Z, WS_WGU1 = WS_Z + 88 * MiB, WS_WD1 = WS_Z + 99 * MiB;
constexpr size_t WS_Q = WS_Z, WS_K = WS_Z + 16 * MiB, WS_VT = WS_Z + 32 * MiB, WS_XR = WS_Z + 48 * MiB, WS_GY = WS_Z + 80 * MiB, WS_SGA = WS_Z + 112 * MiB, WS_SGR = WS_Z + 144 * MiB;
constexpr size_t WS_END = WS_Z + 176 * MiB;
static_assert(WS_END <= 256 * MiB, "ws map");

using pg8::bflo; using pg8::bfhi; using pg8::fsig;
struct Params { const float* in[22]; float* out; unsigned char* ws; int ph_lo, ph_hi; };

__device__ __forceinline__ float wave_sum(float v) {
#pragma unroll
    for (int o = 1; o < 64; o <<= 1) v += __shfl_xor(v, o);
    return v;
}
__device__ __forceinline__ unsigned pk2(float lo, float hi) { return pg8::cvt_pk_bf16(lo, hi); }
__device__ __forceinline__ bf16_t f2bf(float v) { return (bf16_t)(pg8::cvt_pk_bf16(v, 0.f) & 0xffffu); }
__device__ __forceinline__ float bf2f(bf16_t b) { return __uint_as_float((unsigned)b << 16); }
__device__ __forceinline__ int crow(int r, int hi) { return (r & 3) + 8 * (r >> 2) + 4 * hi; }
#define LDS_WAIT() asm volatile("s_waitcnt lgkmcnt(0)" ::: "memory")

__device__ __forceinline__ void transpose_item(const float* W, int K, int N, bf16_t* WT, int drow0, int k0, int n0, LAS float* scr, int lane) {
#pragma unroll 8
    for (int i = 0; i < 32; ++i) { const int kk = 2 * i + (lane >> 5); scr[kk * 33 + (lane & 31)] = W[(size_t)(k0 + kk) * N + n0 + (lane & 31)]; }
    LDS_WAIT();
    const int c = lane & 7;
#pragma unroll
    for (int j = 0; j < 4; ++j) { const int n = (lane >> 3) + 8 * j; const LAS float* s = scr + (8 * c) * 33 + n;
        u32x4 o; o.x = pk2(s[0 * 33], s[1 * 33]); o.y = pk2(s[2 * 33], s[3 * 33]); o.z = pk2(s[4 * 33], s[5 * 33]); o.w = pk2(s[6 * 33], s[7 * 33]);
        *(u32x4*)(WT + (size_t)(drow0 + n) * K + k0 + 8 * c) = o; }
    LDS_WAIT();
}
__device__ __forceinline__ int gu_row(int n0) { return n0 < FF ? 256 * (n0 >> 7) + (n0 & 127) : 256 * ((n0 - FF) >> 7) + 128 + ((n0 - FF) & 127); }
__device__ __forceinline__ void tr_plain(const float* W, int K, int N, bf16_t* WT, int it, LAS float* scr, int lane) { const int nblk = N / 32, kb = it / nblk, nb = it % nblk; transpose_item(W, K, N, WT, 32 * nb, 64 * kb, 32 * nb, scr, lane); }
__device__ __forceinline__ void tr_gu(const float* W, bf16_t* WT, int it, LAS float* scr, int lane) { const int nblk = NPROJ / 32, kb = it / nblk, nb = it % nblk; transpose_item(W, D, NPROJ, WT, gu_row(32 * nb), 64 * kb, 32 * nb, scr, lane); }

__device__ __forceinline__ void p0_prologue(const Params& p, LAS unsigned char* lds, int tid, int wave, int lane) {
    unsigned char* ws = p.ws;
    for (int cb = blockIdx.x; cb < 144; cb += gridDim.x) {
        const float* c = p.in[1]; const float* w_ada = p.in[2]; const float* b_ada = p.in[3]; float* MOD = (float*)(ws + WS_MOD);
        LAS float* ca = (LAS float*)lds + wave * 512; LAS float* red = (LAS float*)(lds + 32768);
        for (int i = lane; i < 512; i += 64) { const float v = c[(i >> 7) * 1024 + wave * 128 + (i & 127)]; ca[i] = v / (1.f + __expf(-v)); }
        LDS_WAIT();
        const int j = cb * 64 + lane; float a0 = 0.f, a1 = 0.f, a2 = 0.f, a3 = 0.f;
        const float* wp = w_ada + (size_t)(wave * 128) * 9216 + j;
#pragma unroll 16
        for (int kk = 0; kk < 128; ++kk) { const float w = wp[(size_t)kk * 9216]; a0 += ca[kk] * w; a1 += ca[128 + kk] * w; a2 += ca[256 + kk] * w; a3 += ca[384 + kk] * w; }
        red[(wave * 4 + 0) * 64 + lane] = a0; red[(wave * 4 + 1) * 64 + lane] = a1; red[(wave * 4 + 2) * 64 + lane] = a2; red[(wave * 4 + 3) * 64 + lane] = a3;
        __syncthreads();
        if (wave < 4) { float s = b_ada[j];
#pragma unroll
            for (int w8 = 0; w8 < 8; ++w8) s += red[(w8 * 4 + wave) * 64 + lane];
            MOD[wave * 9216 + j] = s; }
        __syncthreads();
    }
    if (blockIdx.x == gridDim.x - 1) { const float* rb = p.in[9]; float* bt = (float*)(ws + WS_BIAS); for (int i = tid; i < 8 * 257; i += NTHREADS) bt[i] = rb[i] * LOG2E; }
    LAS float* scr = (LAS float*)(lds + wave * 16384);
    const int gw = blockIdx.x * NWAVES + wave, NGW = gridDim.x * NWAVES;
    constexpr int I_GU = 16 * 176, I_DN = 44 * 32, I_AO = 8 * 32, I_SQ = 16 * 32, I_LRU = 32 * 2;
    constexpr int NITEMS = 3 * I_GU + 2 * I_DN + I_AO + 2 * I_SQ + I_LRU;
    for (int it = gw; it < NITEMS; it += NGW) {
        int r = it;
        if (r < I_GU) { tr_gu(p.in[6], (bf16_t*)(ws + WS_WGU1), r, scr, lane); continue; } r -= I_GU;
        if (r < I_DN) { tr_plain(p.in[7], FF, D, (bf16_t*)(ws + WS_WD1), r, scr, lane); continue; } r -= I_DN;
        if (r < I_GU) { tr_plain(p.in[8], D, NPROJ, (bf16_t*)(ws + WS_WIN), r, scr, lane); continue; } r -= I_GU;
        if (r < I_AO) { tr_plain(p.in[17], 512, D, (bf16_t*)(ws + WS_WAO), r, scr, lane); continue; } r -= I_AO;
        if (r < I_SQ) { tr_plain(p.in[18], D, D, (bf16_t*)(ws + WS_WRO), r, scr, lane); continue; } r -= I_SQ;
        if (r < I_SQ) { tr_plain(p.in[19], D, D, (bf16_t*)(ws + WS_WOUT), r, scr, lane); continue; } r -= I_SQ;
        if (r < I_GU) { tr_gu(p.in[20], (bf16_t*)(ws + WS_WGU2), r, scr, lane); continue; } r -= I_GU;
        if (r < I_DN) { tr_plain(p.in[21], FF, D, (bf16_t*)(ws + WS_WD2), r, scr, lane); continue; } r -= I_DN;
        { const int mtx = r >> 1, half = r & 1, which = mtx >> 4, blk = mtx & 15;
          transpose_item(p.in[which ? 14 : 12] + blk * 4096, 64, 64, (bf16_t*)(ws + (which ? WS_LRUWX : WS_LRUWA)) + blk * 4096, 32 * half, 0, 32 * half, scr, lane); }
    }
}

template <int MODE> __device__ __forceinline__ void row_phase(const Params& p, int cur, int nxt, float resw, const float* xin, float* xout, int wave, int lane) {
    unsigned char* ws = p.ws; bf16_t* YH = (bf16_t*)(ws + WS_HB); const float* ssq = (const float*)(ws + WS_SSQ); const float* MOD = (const float*)(ws + WS_MOD);
    const float* npre = p.in[4]; const float* npost = p.in[5];
    const int gw = blockIdx.x * NWAVES + wave, NGW = gridDim.x * NWAVES;
    for (int m = gw; m < M; m += NGW) {
        const int b = m >> 12; f32x4 x[4];
#pragma unroll
        for (int j = 0; j < 4; ++j) x[j] = *(const f32x4*)(xin + (size_t)m * D + 4 * lane + 256 * j);
        if (MODE != 0) {
            float sq = lane < 16 ? ssq[(size_t)m * 16 + lane] : 0.f; sq = wave_sum(sq);
            const float ry = __builtin_amdgcn_rsqf(sq * (1.f / D) + EPS);
#pragma unroll
            for (int j = 0; j < 4; ++j) { const int c = 4 * lane + 256 * j;
                const u32x2 yw = *(const u32x2*)(YH + (size_t)m * D + c);
                const f32x4 g = *(const f32x4*)(MOD + b * 9216 + cur * 3072 + 2048 + c), gp = *(const f32x4*)(npost + cur * 1024 + c);
                x[j][0] += resw * g[0] * (bflo(yw.x) * ry * gp[0]); x[j][1] += resw * g[1] * (bfhi(yw.x) * ry * gp[1]);
                x[j][2] += resw * g[2] * (bflo(yw.y) * ry * gp[2]); x[j][3] += resw * g[3] * (bfhi(yw.y) * ry * gp[3]);
                *(f32x4*)(xout + (size_t)m * D + c) = x[j]; }
        }
        if (MODE != 2) {
            float s2 = 0.f;
#pragma unroll
            for (int j = 0; j < 4; ++j) s2 += (x[j][0] * x[j][0] + x[j][1] * x[j][1]) + (x[j][2] * x[j][2] + x[j][3] * x[j][3]);
            s2 = wave_sum(s2); const float rx = __builtin_amdgcn_rsqf(s2 * (1.f / D) + EPS);
#pragma unroll
            for (int j = 0; j < 4; ++j) { const int c = 4 * lane + 256 * j;
                const f32x4 gp = *(const f32x4*)(npre + nxt * 1024 + c), sc = *(const f32x4*)(MOD + b * 9216 + nxt * 3072 + 1024 + c), sh = *(const f32x4*)(MOD + b * 9216 + nxt * 3072 + c);
                float h[4];
#pragma unroll
                for (int e = 0; e < 4; ++e) h[e] = x[j][e] * rx * gp[e] * (1.f + sc[e]) + sh[e];
                u32x2 w; w.x = pk2(h[0], h[1]); w.y = pk2(h[2], h[3]); *(u32x2*)(YH + (size_t)m * D + c) = w; }
        }
    }
}
#define MFMA32(a, b, c) __builtin_amdgcn_mfma_f32_32x32x16_bf16((a), (b), (c), 0, 0, 0)
__device__ __forceinline__ void attn_phase(const Params& p, LAS unsigned char* lds, int tid, int wave, int lane) {
    unsigned char* ws = p.ws;
    const bf16_t* Qb = (const bf16_t*)(ws + WS_Q); const bf16_t* Kb = (const bf16_t*)(ws + WS_K); const bf16_t* Vt = (const bf16_t*)(ws + WS_VT); bf16_t* Ob = (bf16_t*)(ws + WS_Q);
    LAS float* BT = (LAS float*)lds; const float* bias2 = (const float*)(ws + WS_BIAS);
    for (int i = tid; i < 8 * 257; i += NTHREADS) BT[i] = bias2[i];
    __syncthreads();
    const int r32 = lane & 31, hi = lane >> 5, h = wave;
    const LAS float* BTh = BT + h * 257;
    const float cfar = BTh[256];
    for (int unit = blockIdx.x; unit < 256; unit += gridDim.x) {
        const int b = unit >> 6, n = unit & 63;
        for (int qb = 0; qb < 2; ++qb) {
            const int q = qb * 32 + r32; const size_t rowq = (size_t)b * SEQ + n * 64 + q;
            bf16x8 qf[4];
#pragma unroll
            for (int d0 = 0; d0 < 4; ++d0) qf[d0] = *(const bf16x8*)(Qb + rowq * 512 + h * 64 + d0 * 16 + hi * 8);
            f32x16 o0, o1;
#pragma unroll
            for (int r = 0; r < 16; ++r) { o0[r] = 0.f; o1[r] = 0.f; }
            float mrun = -1e30f, lrun = 0.f;
            const int jlo = n >= 8 ? 0 : 8 - n;
            for (int j = jlo; j <= 8; ++j) {
                const int kc = n - 8 + j; const size_t krow0 = (size_t)b * SEQ + kc * 64;
                f32x16 s0, s1;
#pragma unroll
                for (int r = 0; r < 16; ++r) { s0[r] = 0.f; s1[r] = 0.f; }
                const bf16_t* kp = Kb + (krow0 + r32) * 512 + h * 64 + hi * 8;
                bf16x8 k0[4], k1[4];
#pragma unroll
                for (int d0 = 0; d0 < 4; ++d0) { k0[d0] = *(const bf16x8*)(kp + d0 * 16); k1[d0] = *(const bf16x8*)(kp + 32 * 512 + d0 * 16); }
                const bf16_t* vp = Vt + (((size_t)(b * 512 + h * 64 + r32)) << 12) + kc * 64 + 4 * hi;
                bf16x8 vf[2][2][2];
#pragma unroll
                for (int db = 0; db < 2; ++db)
#pragma unroll
                    for (int kb = 0; kb < 2; ++kb)
#pragma unroll
                        for (int sp = 0; sp < 2; ++sp) { const bf16_t* a = vp + ((size_t)(db * 32) << 12) + kb * 32 + sp * 16; const u32x2 lo = *(const u32x2*)a, hh = *(const u32x2*)(a + 8);
                            const u32x4 w = (u32x4){lo.x, lo.y, hh.x, hh.y}; vf[db][kb][sp] = __builtin_bit_cast(bf16x8, w); }
#pragma unroll
                for (int d0 = 0; d0 < 4; ++d0) { s0 = MFMA32(k0[d0], qf[d0], s0); s1 = MFMA32(k1[d0], qf[d0], s1); }
                if (j <= 5) {
#pragma unroll
                    for (int r = 0; r < 16; ++r) { s0[r] += cfar; s1[r] += cfar; }
                } else {
                    const int base = q + 64 * (8 - j) - 4 * hi + 128;
#pragma unroll
                    for (int r = 0; r < 16; ++r) { const int kv = (r & 3) + 8 * (r >> 2); int i0 = base - kv, i1 = base - kv - 32;
                        i0 = i0 < 0 ? 0 : (i0 > 256 ? 256 : i0); i1 = i1 < 0 ? 0 : (i1 > 256 ? 256 : i1); s0[r] += BTh[i0]; s1[r] += BTh[i1]; }
                }
                float mx = fmaxf(s0[0], s1[0]);
#pragma unroll
                for (int r = 1; r < 16; ++r) mx = fmaxf(mx, fmaxf(s0[r], s1[r]));
                mx = fmaxf(mx, __shfl_xor(mx, 32));
                const float mnew = fmaxf(mrun, mx), alpha = __builtin_amdgcn_exp2f(mrun - mnew); mrun = mnew;
                float rs = 0.f;
#pragma unroll
                for (int r = 0; r < 16; ++r) { s0[r] = __builtin_amdgcn_exp2f(s0[r] - mnew); s1[r] = __builtin_amdgcn_exp2f(s1[r] - mnew); rs += s0[r] + s1[r]; }
                lrun = lrun * alpha + rs;
#pragma unroll
                for (int r = 0; r < 16; ++r) { o0[r] *= alpha; o1[r] *= alpha; }
                bf16x8 pf[2][2];
#pragma unroll
                for (int sp = 0; sp < 2; ++sp) {
                    u32x4 w0, w1;
                    w0.x = pk2(s0[8 * sp + 0], s0[8 * sp + 1]); w0.y = pk2(s0[8 * sp + 2], s0[8 * sp + 3]); w0.z = pk2(s0[8 * sp + 4], s0[8 * sp + 5]); w0.w = pk2(s0[8 * sp + 6], s0[8 * sp + 7]);
                    w1.x = pk2(s1[8 * sp + 0], s1[8 * sp + 1]); w1.y = pk2(s1[8 * sp + 2], s1[8 * sp + 3]); w1.z = pk2(s1[8 * sp + 4], s1[8 * sp + 5]); w1.w = pk2(s1[8 * sp + 6], s1[8 * sp + 7]);
                    pf[0][sp] = __builtin_bit_cast(bf16x8, w0); pf[1][sp] = __builtin_bit_cast(bf16x8, w1);
                }
#pragma unroll
                for (int kb = 0; kb < 2; ++kb)
#pragma unroll
                    for (int sp = 0; sp < 2; ++sp) { o0 = MFMA32(vf[0][kb][sp], pf[kb][sp], o0); o1 = MFMA32(vf[1][kb][sp], pf[kb][sp], o1); }
            }
            lrun += __shfl_xor(lrun, 32); const float inv = 1.f / lrun;
            bf16_t* op = Ob + rowq * 512 + h * 64 + 4 * hi;
#pragma unroll
            for (int g = 0; g < 4; ++g) {
                u32x2 w; w.x = pk2(o0[4 * g] * inv, o0[4 * g + 1] * inv); w.y = pk2(o0[4 * g + 2] * inv, o0[4 * g + 3] * inv); *(u32x2*)(op + 8 * g) = w;
                u32x2 v; v.x = pk2(o1[4 * g] * inv, o1[4 * g + 1] * inv); v.y = pk2(o1[4 * g + 2] * inv, o1[4 * g + 3] * inv); *(u32x2*)(op + 32 + 8 * g) = v;
            }
        }
    }
}

template <bool PASS2> __device__ __forceinline__ void scan_phase(const Params& p, LAS unsigned char* lds, int wave, int lane) {
    unsigned char* ws = p.ws;
    const bf16_t* XR = (const bf16_t*)(ws + WS_XR); bf16_t* GY = (bf16_t*)(ws + WS_GY);
    const bf16_t* WAt = (const bf16_t*)(ws + WS_LRUWA); const bf16_t* WXt = (const bf16_t*)(ws + WS_LRUWX);
    float* SUMA = (float*)(ws + WS_SUMA); float* SUMH = (float*)(ws + WS_SUMH);
    const float *conv_w = p.in[10], *conv_b = p.in[11], *lba = p.in[13], *lbx = p.in[15], *lam = p.in[16];
    constexpr int XP = 72;
    LAS bf16_t* XT = (LAS bf16_t*)(lds + 16384 + wave * 9728);
    const int r32 = lane & 31, hi = lane >> 5;
    for (int unit = blockIdx.x; unit < 256; unit += gridDim.x) {
        const int b = unit >> 6, n = unit & 63;
        for (int bi = 0; bi < 2; ++bi) {
            const int blk = wave + 8 * bi, c0 = blk * 64;
            LDS_WAIT();
#pragma unroll
            for (int it = 0; it < 9; ++it) { const int row = it * 8 + (lane >> 3), ch = (lane & 7) * 8;
                if (row < 67) { const int tpos = n * 64 - 3 + row; u32x4 v = (u32x4){0u, 0u, 0u, 0u};
                    if (tpos >= 0) v = *(const u32x4*)(XR + ((size_t)b * SEQ + tpos) * 1024 + c0 + ch);
                    *(LAS u32x4*)(XT + row * XP + ch) = v; } }
            LDS_WAIT();
            { const int c = c0 + lane; const float w0 = conv_w[c], w1 = conv_w[1024 + c], w2 = conv_w[2048 + c], w3 = conv_w[3072 + c], cb = conv_b[c];
              float x0 = bf2f(XT[0 * XP + lane]), x1 = bf2f(XT[1 * XP + lane]), x2 = bf2f(XT[2 * XP + lane]);
#pragma unroll 8
              for (int t = 0; t < 64; ++t) { const float x3 = bf2f(XT[(t + 3) * XP + lane]); const float xc = cb + w0 * x0 + w1 * x1 + w2 * x2 + w3 * x3; XT[(t + 3) * XP + lane] = f2bf(xc); x0 = x1; x1 = x2; x2 = x3; } }
            LDS_WAIT();
            for (int jb = 0; jb < 2; ++jb) {
                const int j = jb * 32 + r32, ch = c0 + j;
                bf16x8 wa[4], wx[4];
#pragma unroll
                for (int ks = 0; ks < 4; ++ks) { wa[ks] = *(const bf16x8*)(WAt + blk * 4096 + j * 64 + ks * 16 + hi * 8); wx[ks] = *(const bf16x8*)(WXt + blk * 4096 + j * 64 + ks * 16 + hi * 8); }
                float carry = 0.f;
                if (PASS2) { const float* sa = SUMA + (size_t)(b * 64) * 1024 + ch; const float* sh = SUMH + (size_t)(b * 64) * 1024 + ch;
                    for (int k = 0; k < n; ++k) carry = sa[(size_t)k * 1024] * carry + sh[(size_t)k * 1024]; }
                f32x16 aa[2], ax[2];
#pragma unroll
                for (int tb = 0; tb < 2; ++tb) {
#pragma unroll
                    for (int r = 0; r < 16; ++r) { aa[tb][r] = 0.f; ax[tb][r] = 0.f; }
#pragma unroll
                    for (int ks = 0; ks < 4; ++ks) { const bf16x8 xa = *(const LAS bf16x8*)(XT + (3 + tb * 32 + r32) * XP + ks * 16 + hi * 8); aa[tb] = MFMA32(xa, wa[ks], aa[tb]); ax[tb] = MFMA32(xa, wx[ks], ax[tb]); }
                }
                const float ba = lba[ch], bx = lbx[ch], sp8 = 8.f * log1pf(__expf(-lam[ch]));
#pragma unroll
                for (int tb = 0; tb < 2; ++tb)
#pragma unroll
                    for (int r = 0; r < 16; ++r) { const int t = tb * 32 + crow(r, hi); const float xcv = bf2f(XT[(3 + t) * XP + j]);
                        const float ra = fsig(aa[tb][r] + ba), ix = fsig(ax[tb][r] + bx), la = -sp8 * ra, a = __expf(la), mult = sqrtf(-expm1f(2.f * la));
                        aa[tb][r] = a; ax[tb][r] = mult * ix * xcv; }
                float cin[2][4]; float c = carry, ap = 1.f;
#pragma unroll
                for (int tb = 0; tb < 2; ++tb)
#pragma unroll
                    for (int q4 = 0; q4 < 4; ++q4) {
                        const float a0 = aa[tb][4 * q4], a1 = aa[tb][4 * q4 + 1], a2 = aa[tb][4 * q4 + 2], a3 = aa[tb][4 * q4 + 3];
                        const float u0 = ax[tb][4 * q4], u1 = ax[tb][4 * q4 + 1], u2 = ax[tb][4 * q4 + 2], u3 = ax[tb][4 * q4 + 3];
                        const float As = a0 * a1 * a2 * a3, Hs = ((u0 * a1 + u1) * a2 + u2) * a3 + u3;
                        ap *= As;
                        float out = As * c + Hs; const float t1 = __shfl_xor(out, 32);
                        const float ci = hi ? t1 : c; out = As * ci + Hs; const float t2 = __shfl_xor(out, 32);
                        cin[tb][q4] = ci; c = hi ? out : t2;
                    }
                if (!PASS2) {
                    ap *= __shfl_xor(ap, 32);
                    if (hi == 0) { SUMA[(size_t)(b * 64 + n) * 1024 + ch] = ap; SUMH[(size_t)(b * 64 + n) * 1024 + ch] = c; }
                } else {
#pragma unroll
                    for (int tb = 0; tb < 2; ++tb)
#pragma unroll
                        for (int q4 = 0; q4 < 4; ++q4) { float hp = cin[tb][q4];
#pragma unroll
                            for (int e = 0; e < 4; ++e) { const int r = 4 * q4 + e; hp = aa[tb][r] * hp + ax[tb][r];
                                const size_t off = ((size_t)b * SEQ + n * 64 + tb * 32 + 8 * q4 + 4 * hi + e) * 1024 + ch; GY[off] = f2bf(hp * bf2f(GY[off])); } }
                }
            }
        }
    }
}

__global__ void __launch_bounds__(NTHREADS, 2) mk_fwd(Params p) {
    extern __shared__ __attribute__((aligned(16))) unsigned char lds_raw[];
    LAS unsigned char* lds = (LAS unsigned char*)lds_raw;
    cg::grid_group grid = cg::this_grid();
    const int tid = threadIdx.x, lane = tid & 63, wave = __builtin_amdgcn_readfirstlane(tid >> 6);
    unsigned char* ws = p.ws;
    const int lo = p.ph_lo, hi_ = p.ph_hi;
#define IN(k) (lo <= (k) && (k) < hi_)
#define SEAM(k) do { if (IN((k) + 1)) grid.sync(); } while (0)
    bf16_t* HB = (bf16_t*)(ws + WS_HB); bf16_t* ACT = (bf16_t*)(ws + WS_ACT); float* SSQ = (float*)(ws + WS_SSQ);
    const int G = gridDim.x, bx = blockIdx.x;
    if (IN(0)) { p0_prologue(p, lds, tid, wave, lane); SEAM(0); }
    if (IN(1)) { row_phase<0>(p, 0, 0, 0.f, p.in[0], nullptr, wave, lane); SEAM(1); }
    if (IN(2)) { pg8::Gemm g{HB, (const bf16_t*)(ws + WS_WGU1), M, NPROJ, D}; pg8::StaticOrder S; S.init(M, NPROJ, G, bx); pg8::EpiSwiglu E{ACT, FF};
        pg8::gemm_phase<pg8::EpiSwiglu, pg8::StaticOrder, true, true>(lds, g, S, E); SEAM(2); }
    if (IN(3)) { pg8::Gemm g{ACT, (const bf16_t*)(ws + WS_WD1), M, D, FF}; pg8::StaticOrder S; S.init(M, D, G, bx); pg8::EpiY E{HB, SSQ};
        pg8::gemm_phase<pg8::EpiY, pg8::StaticOrder, true, true>(lds, g, S, E); SEAM(3); }
    if (IN(4)) { row_phase<1>(p, 0, 1, 0.5f, p.in[0], p.out, wave, lane); SEAM(4); }
    if (IN(5)) { pg8::Gemm g{HB, (const bf16_t*)(ws + WS_WIN), M, NPROJ, D}; pg8::StaticOrder S; S.init(M, NPROJ, G, bx);
        pg8::EpiProj E{(bf16_t*)(ws + WS_Q), (bf16_t*)(ws + WS_K), (bf16_t*)(ws + WS_VT), (bf16_t*)(ws + WS_XR), (bf16_t*)(ws + WS_GY), (bf16_t*)(ws + WS_SGA), (bf16_t*)(ws + WS_SGR), 0.125f * LOG2E};
        pg8::gemm_phase<pg8::EpiProj, pg8::StaticOrder, true, true>(lds, g, S, E); SEAM(5); }
    if (IN(6)) { attn_phase(p, lds, tid, wave, lane); scan_phase<false>(p, lds, wave, lane); SEAM(6); }
    if (IN(7)) { scan_phase<true>(p, lds, wave, lane); __syncthreads();
        pg8::Gemm g{(const bf16_t*)(ws + WS_Q), (const bf16_t*)(ws + WS_WAO), M, D, 512}; pg8::StaticOrder S; S.init(M, D, G, bx); pg8::EpiGate<false> E{(const bf16_t*)(ws + WS_SGA), (bf16_t*)(ws + WS_SGA)};
        pg8::gemm_phase<pg8::EpiGate<false>, pg8::StaticOrder, true, true>(lds, g, S, E); SEAM(7); }
    if (IN(8)) { pg8::Gemm g{(const bf16_t*)(ws + WS_GY), (const bf16_t*)(ws + WS_WRO), M, D, D}; pg8::StaticOrder S; S.init(M, D, G, bx); pg8::EpiGate<true> E{(const bf16_t*)(ws + WS_SGR), (bf16_t*)(ws + WS_SGA)};
        pg8::gemm_phase<pg8::EpiGate<true>, pg8::StaticOrder, true, true>(lds, g, S, E); SEAM(8); }
    if (IN(9)) { pg8::Gemm g{(const bf16_t*)(ws + WS_SGA), (const bf16_t*)(ws + WS_WOUT), M, D, D}; pg8::StaticOrder S; S.init(M, D, G, bx); pg8::EpiY E{HB, SSQ};
        pg8::gemm_phase<pg8::EpiY, pg8::StaticOrder, true, true>(lds, g, S, E); SEAM(9); }
    if (IN(10)) { row_phase<1>(p, 1, 2, 1.0f, p.out, p.out, wave, lane); SEAM(10); }
    if (IN(11)) { pg8::Gemm g{HB, (const bf16_t*)(ws + WS_WGU2), M, NPROJ, D}; pg8::StaticOrder S; S.init(M, NPROJ, G, bx); pg8::EpiSwiglu E{ACT, FF};
        pg8::gemm_phase<pg8::EpiSwiglu, pg8::StaticOrder, true, true>(lds, g, S, E); SEAM(11); }
    if (IN(12)) { pg8::Gemm g{ACT, (const bf16_t*)(ws + WS_WD2), M, D, FF}; pg8::StaticOrder S; S.init(M, D, G, bx); pg8::EpiY E{HB, SSQ};
        pg8::gemm_phase<pg8::EpiY, pg8::StaticOrder, true, true>(lds, g, S, E); SEAM(12); }
    if (IN(13)) { row_phase<2>(p, 2, 2, 0.5f, p.out, p.out, wave, lane); }
#undef IN
#undef SEAM
}

extern "C" void kernel_launch(void* const* d_in, const int* in_sizes, int n_in, void* d_out, int out_size, void* d_ws, size_t ws_size, hipStream_t stream) {
    static int grid = 0;
    if (grid == 0) {
        int dev = 0, cus = 0, per_cu = 0;
        (void)hipGetDevice(&dev); (void)hipDeviceGetAttribute(&cus, hipDeviceAttributeMultiprocessorCount, dev);
        (void)hipFuncSetAttribute((const void*)mk_fwd, hipFuncAttributeMaxDynamicSharedMemorySize, LDS_BYTES);
        (void)hipOccupancyMaxActiveBlocksPerMultiprocessor(&per_cu, (const void*)mk_fwd, NTHREADS, LDS_BYTES);
        if (per_cu < 1) { fprintf(stderr, "kernel_launch: occupancy query says %d blocks/CU\n", per_cu); per_cu = 1; }
        (void)hipGetLastError();
        grid = cus * per_cu;
        if (n_in != 22 || ws_size < WS_END) { fprintf(stderr, "kernel_launch: unexpected n_in %d / ws %zu\n", n_in, ws_size); }
    }
    Params p{};
    for (int i = 0; i < 22; ++i) p.in[i] = (const float*)d_in[i];
    p.out = (float*)d_out; p.ws = (unsigned char*)d_ws;
#if MK_MULTI
    for (int k = 0; k < N_PHASES; ++k) { p.ph_lo = k; p.ph_hi = k + 1; hipLaunchKernelGGL(mk_fwd, dim3(grid), dim3(NTHREADS), LDS_BYTES, stream, p); }
#else
    p.ph_lo = 0; p.ph_hi = N_PHASES;
    void* args[] = {&p};
    hipError_t e = hipLaunchCooperativeKernel((const void*)mk_fwd, dim3(grid), dim3(NTHREADS), args, LDS_BYTES, stream);
    if (e != hipSuccess) fprintf(stderr, "cooperative launch failed: %s (grid %d)\n", hipGetErrorString(e), grid);
#endif
}
```

```cpp
#include <hip/hip_runtime.h>
#include <hip/hip_cooperative_groups.h>
#include <cstdio>
#include <cstdint>
namespace cg = cooperative_groups;
#ifndef MK_SEQ
#define MK_SEQ 0, 1, 2, 3, 4, 5, 6, 7, 8, 9, 10, 11, 12, 13
#endif
#ifndef MK_XSYNC
#define MK_XSYNC 0
#endif
#ifndef MK_MULTI
#define MK_MULTI 0
#endif
namespace pg8 {
#define PG8_LAS __attribute__((address_space(3)))
typedef unsigned short bf16_t;
typedef short bf16x8 __attribute__((ext_vector_type(8)));
typedef float f32x4 __attribute__((ext_vector_type(4)));
typedef unsigned u32x4 __attribute__((ext_vector_type(4)));
constexpr int BM = 256, BK = 64, HALF = 128, HTB = HALF * BK * 2  , STAGE_BYTES = 8 * HTB, NXCD = 8, WGM = 8;

__host__ __device__ __forceinline__ int lds_byte(int r, int c) { const int st = (r >> 4) * 2 + (c >> 5), rr = r & 15, cc = c & 31, ob = rr * 64 + cc * 2; return st * 1024 + (ob ^ (((ob >> 9) & 1) << 5)); }
__host__ __device__ __forceinline__ void stage_rc(int b, int& R, int& C) { const int st = b / 1024, sb = b % 1024, swz = sb ^ (((sb >> 9) & 1) << 5); R = (st >> 1) * 16 + swz / 64; C = (st & 1) * 32 + (swz % 64) / 2; }
__host__ __device__ __forceinline__ int perm32(int rho) { const int n = rho >> 4, i = rho & 15; return 8 * (i >> 2) + 4 * n + (i & 3); }

struct Unit { int pm, pn; };
struct Gemm { const bf16_t* A; const bf16_t* Bt; int M, N, K; };

struct StaticOrder {
    int nM, nN, nwg, G, c;
    __host__ __device__ void init(int M, int N, int G_, int c_) { nM = M / BM; nN = N / BM; nwg = nM * nN; G = G_; c = c_; }
    __host__ __device__ bool next(int i, Unit& u) const {
        const long L = (long)i * G + c; if (L >= nwg) return false;
        int wgid = (int)L; { const int q = nwg / NXCD, r = nwg % NXCD, xcd = wgid % NXCD, off = wgid / NXCD; wgid = (xcd < r ? xcd * (q + 1) : r * (q + 1) + (xcd - r) * q) + off; }
        const int nig = WGM * nN, gid = wgid / nig, fm = gid * WGM, gsz = (nM - fm) < WGM ? (nM - fm) : WGM;
        u.pm = fm + ((wgid % nig) % gsz); u.pn = (wgid % nig) / gsz; return true;
    }
    __device__ __forceinline__ void a_ready(const Unit&) const {}
    __device__ __forceinline__ void done(const Unit&) const {}
};

__device__ __forceinline__ unsigned cvt_pk_bf16(float lo, float hi) { unsigned r; asm volatile("v_cvt_pk_bf16_f32 %0, %1, %2" : "=v"(r) : "v"(lo), "v"(hi)); return r; }
typedef float f32x2 __attribute__((ext_vector_type(2)));
typedef unsigned u32x2 __attribute__((ext_vector_type(2)));
__device__ __forceinline__ float fsig(float x) { return __builtin_amdgcn_rcpf(1.f + __builtin_amdgcn_exp2f(-1.4426950408889634f * x)); }
__device__ __forceinline__ float bflo(unsigned w) { return __uint_as_float(w << 16); }
__device__ __forceinline__ float bfhi(unsigned w) { return __uint_as_float(w & 0xffff0000u); }
__device__ __forceinline__ u32x4 pack8(const float* o) { u32x4 w; w.x = cvt_pk_bf16(o[0], o[1]); w.y = cvt_pk_bf16(o[2], o[3]); w.z = cvt_pk_bf16(o[4], o[5]); w.w = cvt_pk_bf16(o[6], o[7]); return w; }

struct EpiSwiglu {
    static constexpr bool PERM = true, AFTER_DRAIN = false;
    bf16_t* O; int ldc;
    __device__ __forceinline__ void operator()(const f32x4 (&acc)[2][2][4][2], const Unit& u, int wr, int wc, int fr, int fq) const {
        const int row0 = u.pm * BM + wr * 64 + fr, col0 = u.pn * HALF + wc * 32 + 8 * fq;
#pragma unroll
        for (int ai = 0; ai < 2; ++ai)
#pragma unroll
            for (int m = 0; m < 4; ++m) {
                float o[8];
#pragma unroll
                for (int n = 0; n < 2; ++n)
#pragma unroll
                    for (int e = 0; e < 4; ++e) { const float g = acc[ai][0][m][n][e], uu = acc[ai][1][m][n][e]; o[n * 4 + e] = g * fsig(g) * uu; }
                *(u32x4*)(O + (size_t)(row0 + ai * HALF + m * 16) * ldc + col0) = pack8(o);
            }
    }
};
struct EpiY {
    static constexpr bool PERM = true, AFTER_DRAIN = false;
    bf16_t* Y; float* ssq;
    __device__ __forceinline__ void operator()(const f32x4 (&acc)[2][2][4][2], const Unit& u, int wr, int wc, int fr, int fq) const {
        const int row0 = u.pm * BM + wr * 64 + fr, col0 = u.pn * BM + wc * 32 + 8 * fq;
#pragma unroll
        for (int ai = 0; ai < 2; ++ai)
#pragma unroll
            for (int m = 0; m < 4; ++m) {
                const int row = row0 + ai * HALF + m * 16; float s = 0.f;
#pragma unroll
                for (int bj = 0; bj < 2; ++bj) {
                    float o[8];
#pragma unroll
                    for (int n = 0; n < 2; ++n)
#pragma unroll
                        for (int e = 0; e < 4; ++e) { const float v = acc[ai][bj][m][n][e]; o[n * 4 + e] = v; s += v * v; }
                    *(u32x4*)(Y + (size_t)row * 1024 + col0 + bj * HALF) = pack8(o);
                }
                s += __shfl_xor(s, 16); s += __shfl_xor(s, 32);
                if (fq == 0) ssq[(size_t)row * 16 + u.pn * 4 + wc] = s;
            }
    }
};
struct EpiProj {
    static constexpr bool PERM = true, AFTER_DRAIN = false;
    bf16_t *Q, *K, *Vt, *XR, *GY, *SGA, *SGR; float qscale;
    __device__ __forceinline__ void operator()(const f32x4 (&acc)[2][2][4][2], const Unit& u, int wr, int wc, int fr, int fq) const {
        const int pn = u.pn, row0 = u.pm * BM + wr * 64 + fr;
        if (pn >= 4 && pn < 6) {
            const int cbase = (pn - 4) * 256 + wc * 32 + 8 * fq;
#pragma unroll
            for (int ai = 0; ai < 2; ++ai)
#pragma unroll
                for (int m = 0; m < 4; ++m) {
                    const int row = row0 + ai * HALF + m * 16, b = row >> 12, s = row & 4095;
#pragma unroll
                    for (int bj = 0; bj < 2; ++bj)
#pragma unroll
                        for (int n = 0; n < 2; ++n) {
                            const f32x4 v = acc[ai][bj][m][n]; const unsigned w0 = cvt_pk_bf16(v[0], v[1]), w1 = cvt_pk_bf16(v[2], v[3]);
                            bf16_t* p = Vt + (((size_t)(b * 512 + cbase + bj * HALF + 4 * n)) << 12) + s;
                            p[0] = (bf16_t)(w0 & 0xffffu); p[4096] = (bf16_t)(w0 >> 16); p[8192] = (bf16_t)(w1 & 0xffffu); p[12288] = (bf16_t)(w1 >> 16);
                        }
                }
            return;
        }
        bf16_t* base; int ld, ct, mode;
        if (pn < 2) { base = Q; ld = 512; ct = pn; mode = 0; }
        else if (pn < 4) { base = K; ld = 512; ct = pn - 2; mode = 1; }
        else if (pn < 10) { base = XR; ld = 1024; ct = pn - 6; mode = 1; }
        else if (pn < 14) { base = GY; ld = 1024; ct = pn - 10; mode = 2; }
        else if (pn < 18) { base = SGA; ld = 1024; ct = pn - 14; mode = 3; }
        else { base = SGR; ld = 1024; ct = pn - 18; mode = 3; }
        const int col0 = ct * 256 + wc * 32 + 8 * fq;
#pragma unroll
        for (int ai = 0; ai < 2; ++ai)
#pragma unroll
            for (int m = 0; m < 4; ++m) {
                bf16_t* rowp = base + (size_t)(row0 + ai * HALF + m * 16) * ld + col0;
#pragma unroll
                for (int bj = 0; bj < 2; ++bj) {
                    float o[8];
#pragma unroll
                    for (int n = 0; n < 2; ++n)
#pragma unroll
                        for (int e = 0; e < 4; ++e) {
                            float v = acc[ai][bj][m][n][e];
                            if (mode == 0) v *= qscale;
                            else if (mode == 2) { const float z = 1.5957691216057308f * (v + 0.044715f * v * v * v); v = v * fsig(z); }
                            else if (mode == 3) v = fsig(v);
                            o[n * 4 + e] = v;
                        }
                    *(u32x4*)(rowp + bj * HALF) = pack8(o);
                }
            }
    }
};
template <bool ADD> struct EpiGate {
    static constexpr bool PERM = true, AFTER_DRAIN = false;
    const bf16_t* gate; const bf16_t* mg; bf16_t* out;
    __device__ __forceinline__ void operator()(const f32x4 (&acc)[2][2][4][2], const Unit& u, int wr, int wc, int fr, int fq) const {
        const int row0 = u.pm * BM + wr * 64 + fr, col0 = u.pn * BM + wc * 32 + 8 * fq;
#pragma unroll
        for (int ai = 0; ai < 2; ++ai)
#pragma unroll
            for (int m = 0; m < 4; ++m)
#pragma unroll
                for (int bj = 0; bj < 2; ++bj) {
                    const size_t off = (size_t)(row0 + ai * HALF + m * 16) * 1024 + col0 + bj * HALF;
                    const u32x4 g = *(const u32x4*)(gate + off); u32x4 a = (u32x4){0u, 0u, 0u, 0u}; if (ADD) a = *(const u32x4*)(mg + off);
                    float o[8];
#pragma unroll
                    for (int n = 0; n < 2; ++n) { const f32x4 v = acc[ai][bj][m][n]; const unsigned g0 = n ? g.z : g.x, g1 = n ? g.w : g.y, a0 = n ? a.z : a.x, a1 = n ? a.w : a.y;
                        o[n * 4 + 0] = bflo(g0) * v[0]; o[n * 4 + 1] = bfhi(g0) * v[1]; o[n * 4 + 2] = bflo(g1) * v[2]; o[n * 4 + 3] = bfhi(g1) * v[3];
                        if (ADD) { o[n * 4 + 0] += bflo(a0); o[n * 4 + 1] += bfhi(a0); o[n * 4 + 2] += bflo(a1); o[n * 4 + 3] += bfhi(a1); } }
                    *(u32x4*)(out + off) = pack8(o);
                }
    }
};

template <class Epi, class Sched, bool ALIGN_EPI = false, bool SP2 = false>
__device__ __forceinline__ void gemm_phase(PG8_LAS unsigned char* lds, const Gemm g, const Sched& S, const Epi& E) {
    const int tid = threadIdx.x, wid = __builtin_amdgcn_readfirstlane(tid >> 6), lane = tid & 63, wr = wid >> 2, wc = wid & 3, fr = lane & 15, fq = lane >> 4;
    const int K = g.K, nt = K / BK;
    unsigned voffA[2], voffB[2];
#pragma unroll
    for (int i = 0; i < 2; ++i) { int R, C; stage_rc(tid * 16 + i * 8192, R, C); const int Rb = Epi::PERM ? ((R & ~31) + perm32(R & 31)) : R;
        voffA[i] = (unsigned)(R * K + C) * 2u; voffB[i] = (unsigned)(Rb * K + C) * 2u; }
    const size_t kstep = (size_t)(BK * 2);
    const size_t hstep = (size_t)HALF * K * 2;
    const size_t tstep = 2 * hstep;
    const unsigned ldsw = (unsigned)wid * 1024u;
    const int aoff = lds_byte(wr * 64 + fr, fq * 8), boff = lds_byte(wc * 32 + fr, fq * 8);
#define PG8_SA(b, h) (((b) * 2 + (h)) * HTB)
#define PG8_SB(b, h) ((4 + (b) * 2 + (h)) * HTB)
#define PG8_STAGE(bufoff, gbase, voff) do { _Pragma("unroll") for (int _i = 0; _i < 2; ++_i) \
        __builtin_amdgcn_global_load_lds((const unsigned*)((const char*)(gbase) + (voff)[_i]), (PG8_LAS unsigned*)(lds + (bufoff) + ldsw + _i * 8192), 16, 0, 0); } while (0)
#define PG8_LDA(dst, b, h) do { _Pragma("unroll") for (int m = 0; m < 4; ++m) _Pragma("unroll") for (int k = 0; k < 2; ++k) dst[m][k] = *(const PG8_LAS bf16x8*)(lds + PG8_SA(b, h) + aoff + m * 2048 + k * 1024); } while (0)
#define PG8_LDB(dst, b, h) do { _Pragma("unroll") for (int n = 0; n < 2; ++n) _Pragma("unroll") for (int k = 0; k < 2; ++k) dst[n][k] = *(const PG8_LAS bf16x8*)(lds + PG8_SB(b, h) + boff + n * 2048 + k * 1024); } while (0)
#define PG8_MMA(ai, bj, At, Bt) do { __builtin_amdgcn_s_setprio(1); _Pragma("unroll") for (int m = 0; m < 4; ++m) _Pragma("unroll") for (int n = 0; n < 2; ++n) _Pragma("unroll") for (int k = 0; k < 2; ++k) \
        acc[ai][bj][m][n] = __builtin_amdgcn_mfma_f32_16x16x32_bf16(Bt[n][k], At[m][k], acc[ai][bj][m][n], 0, 0, 0); __builtin_amdgcn_s_setprio(0); } while (0)
#define PG8_WAIT_V(n) asm volatile("s_waitcnt vmcnt(" #n ")" ::: "memory")
#define PG8_WAIT_L(n) asm volatile("s_waitcnt lgkmcnt(" #n ")" ::: "memory")
#define PG8_BAR __builtin_amdgcn_s_barrier()
#define PG8_SCHED __builtin_amdgcn_sched_barrier(0)
    Unit cur, nxt; int ui = 0;
    if (!S.next(0, cur)) return;
    f32x4 acc[2][2][4][2];
#pragma unroll
    for (int a = 0; a < 2; ++a)
#pragma unroll
        for (int b = 0; b < 2; ++b)
#pragma unroll
            for (int m = 0; m < 4; ++m)
#pragma unroll
                for (int n = 0; n < 2; ++n) acc[a][b][m][n] = (f32x4){0.f, 0.f, 0.f, 0.f};
    bf16x8 At[4][2], B0[2][2], B1[2][2];
    const char* cA = (const char*)g.A + (size_t)cur.pm * tstep; const char* cB = (const char*)g.Bt + (size_t)cur.pn * tstep;
    S.a_ready(cur);
    if constexpr (SP2) {
        PG8_STAGE(PG8_SB(0, 0), cB, voffB); PG8_STAGE(PG8_SB(0, 1), cB + hstep, voffB); PG8_STAGE(PG8_SA(0, 0), cA, voffA); PG8_STAGE(PG8_SA(0, 1), cA + hstep, voffA);
        if (wr == 1) PG8_BAR;
        PG8_WAIT_V(2); PG8_BAR;
        PG8_STAGE(PG8_SB(1, 0), cB + kstep, voffB); PG8_STAGE(PG8_SA(1, 0), cA + kstep, voffA); PG8_STAGE(PG8_SB(1, 1), cB + hstep + kstep, voffB);
        PG8_WAIT_V(6); PG8_BAR;
    } else {
        PG8_STAGE(PG8_SB(0, 0), cB, voffB); PG8_STAGE(PG8_SA(0, 0), cA, voffA); PG8_STAGE(PG8_SB(0, 1), cB + hstep, voffB); PG8_STAGE(PG8_SA(0, 1), cA + hstep, voffA);
        if (wr == 1) PG8_BAR;
        PG8_WAIT_V(4); PG8_BAR;
        PG8_STAGE(PG8_SB(1, 0), cB + kstep, voffB); PG8_STAGE(PG8_SA(1, 0), cA + kstep, voffA); PG8_STAGE(PG8_SB(1, 1), cB + hstep + kstep, voffB);
        PG8_WAIT_V(6); PG8_BAR;
    }
    for (;;) {
        const bool has_next = S.next(ui + 1, nxt);
        const char* nA = has_next ? (const char*)g.A + (size_t)nxt.pm * tstep : cA; const char* nB = has_next ? (const char*)g.Bt + (size_t)nxt.pn * tstep : cB;
        for (int t = 0; t < nt; t += 2) {
            const bool last = (t == nt - 2);
            const char* a1 = cA + (size_t)(t + 1) * kstep;
            const char* a2 = last ? nA : cA + (size_t)(t + 2) * kstep; const char* b2 = last ? nB : cB + (size_t)(t + 2) * kstep;
            const char* a3 = a2 + kstep; const char* b3 = b2 + kstep;
            if (last && has_next) S.a_ready(nxt);
            if constexpr (SP2) {
            PG8_LDB(B0, 0, 0); PG8_LDB(B1, 0, 1); PG8_SCHED; PG8_LDA(At, 0, 0); PG8_STAGE(PG8_SA(1, 1), a1 + hstep, voffA);
            PG8_WAIT_V(8); PG8_WAIT_L(0); PG8_BAR; PG8_MMA(0, 0, At, B0); PG8_MMA(0, 1, At, B1); PG8_BAR; PG8_SCHED;
            PG8_LDA(At, 0, 1); PG8_STAGE(PG8_SB(0, 0), b2, voffB); PG8_STAGE(PG8_SB(0, 1), b2 + hstep, voffB); PG8_STAGE(PG8_SA(0, 0), a2, voffA);
            PG8_WAIT_V(8); PG8_WAIT_L(0); PG8_BAR; PG8_MMA(1, 0, At, B0); PG8_MMA(1, 1, At, B1); PG8_BAR; PG8_SCHED;
            PG8_LDB(B0, 1, 0); PG8_LDB(B1, 1, 1); PG8_SCHED; PG8_LDA(At, 1, 0); PG8_STAGE(PG8_SA(0, 1), a2 + hstep, voffA);
            PG8_WAIT_V(8); PG8_WAIT_L(0); PG8_BAR; PG8_MMA(0, 0, At, B0); PG8_MMA(0, 1, At, B1); PG8_BAR; PG8_SCHED;
            PG8_LDA(At, 1, 1); PG8_STAGE(PG8_SB(1, 0), b3, voffB); PG8_STAGE(PG8_SB(1, 1), b3 + hstep, voffB); PG8_STAGE(PG8_SA(1, 0), a3, voffA);
            PG8_WAIT_V(8); PG8_WAIT_L(0); PG8_BAR; PG8_MMA(1, 0, At, B0); PG8_MMA(1, 1, At, B1); PG8_BAR; PG8_SCHED;
            } else {
            PG8_LDB(B0, 0, 0); PG8_SCHED; PG8_LDA(At, 0, 0); PG8_STAGE(PG8_SA(1, 1), a1 + hstep, voffA);
            PG8_WAIT_L(8); PG8_BAR; PG8_WAIT_L(0); PG8_MMA(0, 0, At, B0); PG8_BAR; PG8_SCHED;
            PG8_LDB(B1, 0, 1); PG8_STAGE(PG8_SB(0, 0), b2, voffB);
            PG8_BAR; PG8_WAIT_L(0); PG8_MMA(0, 1, At, B1); PG8_BAR;
            PG8_LDA(At, 0, 1); PG8_STAGE(PG8_SA(0, 0), a2, voffA);
            PG8_BAR; PG8_WAIT_L(0); PG8_MMA(1, 0, At, B0); PG8_BAR; PG8_SCHED;
            PG8_STAGE(PG8_SB(0, 1), b2 + hstep, voffB);
            PG8_WAIT_V(6); PG8_BAR; PG8_MMA(1, 1, At, B1); PG8_BAR;
            PG8_LDB(B0, 1, 0); PG8_SCHED; PG8_LDA(At, 1, 0); PG8_STAGE(PG8_SA(0, 1), a2 + hstep, voffA);
            PG8_WAIT_L(8); PG8_BAR; PG8_WAIT_L(0); PG8_MMA(0, 0, At, B0); PG8_BAR; PG8_SCHED;
            PG8_LDB(B1, 1, 1); PG8_STAGE(PG8_SB(1, 0), b3, voffB);
            PG8_BAR; PG8_WAIT_L(0); PG8_MMA(0, 1, At, B1); PG8_BAR;
            PG8_LDA(At, 1, 1); PG8_STAGE(PG8_SA(1, 0), a3, voffA);
            PG8_BAR; PG8_WAIT_L(0); PG8_MMA(1, 0, At, B0); PG8_BAR; PG8_SCHED;
            PG8_STAGE(PG8_SB(1, 1), b3 + hstep, voffB);
            PG8_WAIT_V(6); PG8_BAR; PG8_MMA(1, 1, At, B1); PG8_BAR;
            }
        }
        if constexpr (ALIGN_EPI) { if (wr == 0) PG8_BAR; }
        if constexpr (!Epi::AFTER_DRAIN) { E(acc, cur, wr, wc, fr, fq); S.done(cur); }
        if (!has_next) break;
#pragma unroll
        for (int a = 0; a < 2; ++a)
#pragma unroll
            for (int b = 0; b < 2; ++b)
#pragma unroll
                for (int m = 0; m < 4; ++m)
#pragma unroll
                    for (int n = 0; n < 2; ++n) acc[a][b][m][n] = (f32x4){0.f, 0.f, 0.f, 0.f};
        cur = nxt; cA = nA; cB = nB; ++ui;
        if constexpr (ALIGN_EPI) { if (wr == 1) PG8_BAR; }
    }
    PG8_WAIT_V(0);
    if constexpr (!ALIGN_EPI) { if (wr == 0) PG8_BAR; }
    PG8_BAR;
    if constexpr (Epi::AFTER_DRAIN) { E.fused(acc, cur, wr, wc, fr, fq, lds, wid, lane); S.done(cur); }
#undef PG8_SA
#undef PG8_SB
#undef PG8_STAGE
#undef PG8_LDA
#undef PG8_LDB
#undef PG8_MMA
#undef PG8_WAIT_V
#undef PG8_WAIT_L
#undef PG8_BAR
#undef PG8_SCHED
}
}
#define LAS __attribute__((address_space(3)))
typedef unsigned short bf16_t;
typedef short bf16x8 __attribute__((ext_vector_type(8)));
typedef float f32x4 __attribute__((ext_vector_type(4)));
typedef float f32x16 __attribute__((ext_vector_type(16)));
typedef unsigned u32x4 __attribute__((ext_vector_type(4)));
typedef unsigned u32x2 __attribute__((ext_vector_type(2)));

constexpr int M = 16384, D = 1024, FF = 2816, SEQ = 4096, NB = 4, NPROJ = 5632;
constexpr float EPS = 1e-6f, LOG2E = 1.4426950408889634f;
constexpr int NWAVES = 8, NTHREADS = 512, LDS_BYTES = 132096;
constexpr int N_PHASES = 14;
constexpr size_t MiB = 1u << 20;
constexpr size_t WS_MOD = 0;
constexpr size_t WS_BIAS = 256 * 1024;
constexpr size_t WS_LRUWA = 512 * 1024, WS_LRUWX = 640 * 1024;
constexpr size_t WS_BAR = 768 * 1024, BAR_BYTES = 16384;
constexpr size_t WS_SSQ = 1 * MiB;
constexpr size_t WS_SUMA = 2 * MiB, WS_SUMH = 3 * MiB;
constexpr size_t WS_WIN = 4 * MiB, WS_WAO = 15 * MiB, WS_WRO = 16 * MiB, WS_WOUT = 18 * MiB, WS_WGU2 = 20 * MiB, WS_WD2 = 31 * MiB;
constexpr size_t WS_HB = 38 * MiB;
constexpr size_t WS_Z = 70 * MiB;
constexpr size_t WS_ACT = WS_Z, WS_WGU1 = WS_Z + 88 * MiB, WS_WD1 = WS_Z + 99 * MiB;
constexpr size_t WS_Q = WS_Z, WS_K = WS_Z + 16 * MiB, WS_VT = WS_Z + 32 * MiB, WS_XR = WS_Z + 48 * MiB, WS_GY = WS_Z + 80 * MiB, WS_SGA = WS_Z + 112 * MiB, WS_SGR = WS_Z + 144 * MiB;
constexpr size_t WS_END = WS_Z + 176 * MiB;
static_assert(WS_END <= 256 * MiB, "ws map");

using pg8::bflo; using pg8::bfhi; using pg8::fsig;
struct Params { const float* in[22]; float* out; unsigned char* ws; int ph_lo, ph_hi, dry, pad; };

__device__ __forceinline__ float wave_sum(float v) {
#pragma unroll
    for (int o = 1; o < 64; o <<= 1) v += __shfl_xor(v, o);
    return v;
}
__device__ __forceinline__ unsigned pk2(float lo, float hi) { return pg8::cvt_pk_bf16(lo, hi); }
__device__ __forceinline__ bf16_t f2bf(float v) { return (bf16_t)(pg8::cvt_pk_bf16(v, 0.f) & 0xffffu); }
__device__ __forceinline__ float bf2f(bf16_t b) { return __uint_as_float((unsigned)b << 16); }
__device__ __forceinline__ int crow(int r, int hi) { return (r & 3) + 8 * (r >> 2) + 4 * hi; }
#define LDS_WAIT() asm volatile("s_waitcnt lgkmcnt(0)" ::: "memory")

__device__ __forceinline__ void transpose_item(const float* W, int K, int N, bf16_t* WT, int drow0, int k0, int n0, LAS float* scr, int lane) {
#pragma unroll 8
    for (int i = 0; i < 32; ++i) { const int kk = 2 * i + (lane >> 5); scr[kk * 33 + (lane & 31)] = W[(size_t)(k0 + kk) * N + n0 + (lane & 31)]; }
    LDS_WAIT();
    const int c = lane & 7;
#pragma unroll
    for (int j = 0; j < 4; ++j) { const int n = (lane >> 3) + 8 * j; const LAS float* s = scr + (8 * c) * 33 + n;
        u32x4 o; o.x = pk2(s[0 * 33], s[1 * 33]); o.y = pk2(s[2 * 33], s[3 * 33]); o.z = pk2(s[4 * 33], s[5 * 33]); o.w = pk2(s[6 * 33], s[7 * 33]);
        *(u32x4*)(WT + (size_t)(drow0 + n) * K + k0 + 8 * c) = o; }
    LDS_WAIT();
}
__device__ __forceinline__ int gu_row(int n0) { return n0 < FF ? 256 * (n0 >> 7) + (n0 & 127) : 256 * ((n0 - FF) >> 7) + 128 + ((n0 - FF) & 127); }
__device__ __forceinline__ void tr_plain(const float* W, int K, int N, bf16_t* WT, int it, LAS float* scr, int lane) { const int nblk = N / 32, kb = it / nblk, nb = it % nblk; transpose_item(W, K, N, WT, 32 * nb, 64 * kb, 32 * nb, scr, lane); }
__device__ __forceinline__ void tr_gu(const float* W, bf16_t* WT, int it, LAS float* scr, int lane) { const int nblk = NPROJ / 32, kb = it / nblk, nb = it % nblk; transpose_item(W, D, NPROJ, WT, gu_row(32 * nb), 64 * kb, 32 * nb, scr, lane); }

__device__ __forceinline__ void p0_prologue(const Params& p, LAS unsigned char* lds, int tid, int wave, int lane) {
    unsigned char* ws = p.ws;
    for (int cb = blockIdx.x; cb < 144; cb += gridDim.x) {
        const float* c = p.in[1]; const float* w_ada = p.in[2]; const float* b_ada = p.in[3]; float* MOD = (float*)(ws + WS_MOD);
        LAS float* ca = (LAS float*)lds + wave * 512; LAS float* red = (LAS float*)(lds + 32768);
        for (int i = lane; i < 512; i += 64) { const float v = c[(i >> 7) * 1024 + wave * 128 + (i & 127)]; ca[i] = v / (1.f + __expf(-v)); }
        LDS_WAIT();
        const int j = cb * 64 + lane; float a0 = 0.f, a1 = 0.f, a2 = 0.f, a3 = 0.f;
        const float* wp = w_ada + (size_t)(wave * 128) * 9216 + j;
#pragma unroll 16
        for (int kk = 0; kk < 128; ++kk) { const float w = wp[(size_t)kk * 9216]; a0 += ca[kk] * w; a1 += ca[128 + kk] * w; a2 += ca[256 + kk] * w; a3 += ca[384 + kk] * w; }
        red[(wave * 4 + 0) * 64 + lane] = a0; red[(wave * 4 + 1) * 64 + lane] = a1; red[(wave * 4 + 2) * 64 + lane] = a2; red[(wave * 4 + 3) * 64 + lane] = a3;
        __syncthreads();
        if (wave < 4) { float s = b_ada[j];
#pragma unroll
            for (int w8 = 0; w8 < 8; ++w8) s += red[(w8 * 4 + wave) * 64 + lane];
            MOD[wave * 9216 + j] = s; }
        __syncthreads();
    }
    if (blockIdx.x == gridDim.x - 1) { const float* rb = p.in[9]; float* bt = (float*)(ws + WS_BIAS); for (int i = tid; i < 8 * 257; i += NTHREADS) bt[i] = rb[i] * LOG2E; }
    LAS float* scr = (LAS float*)(lds + wave * 16384);
    const int gw = blockIdx.x * NWAVES + wave, NGW = gridDim.x * NWAVES;
    constexpr int I_GU = 16 * 176, I_DN = 44 * 32, I_AO = 8 * 32, I_SQ = 16 * 32, I_LRU = 32 * 2;
    constexpr int NITEMS = 3 * I_GU + 2 * I_DN + I_AO + 2 * I_SQ + I_LRU;
    for (int it = gw; it < NITEMS; it += NGW) {
        int r = it;
        if (r < I_GU) { tr_gu(p.in[6], (bf16_t*)(ws + WS_WGU1), r, scr, lane); continue; } r -= I_GU;
        if (r < I_DN) { tr_plain(p.in[7], FF, D, (bf16_t*)(ws + WS_WD1), r, scr, lane); continue; } r -= I_DN;
        if (r < I_GU) { tr_plain(p.in[8], D, NPROJ, (bf16_t*)(ws + WS_WIN), r, scr, lane); continue; } r -= I_GU;
        if (r < I_AO) { tr_plain(p.in[17], 512, D, (bf16_t*)(ws + WS_WAO), r, scr, lane); continue; } r -= I_AO;
        if (r < I_SQ) { tr_plain(p.in[18], D, D, (bf16_t*)(ws + WS_WRO), r, scr, lane); continue; } r -= I_SQ;
        if (r < I_SQ) { tr_plain(p.in[19], D, D, (bf16_t*)(ws + WS_WOUT), r, scr, lane); continue; } r -= I_SQ;
        if (r < I_GU) { tr_gu(p.in[20], (bf16_t*)(ws + WS_WGU2), r, scr, lane); continue; } r -= I_GU;
        if (r < I_DN) { tr_plain(p.in[21], FF, D, (bf16_t*)(ws + WS_WD2), r, scr, lane); continue; } r -= I_DN;
        { const int mtx = r >> 1, half = r & 1, which = mtx >> 4, blk = mtx & 15;
          transpose_item(p.in[which ? 14 : 12] + blk * 4096, 64, 64, (bf16_t*)(ws + (which ? WS_LRUWX : WS_LRUWA)) + blk * 4096, 32 * half, 0, 32 * half, scr, lane); }
    }
}

template <int MODE> __device__ __forceinline__ void row_phase(const Params& p, int cur, int nxt, float resw, const float* xin, float* xout, bf16_t* HO, int wave, int lane) {
    unsigned char* ws = p.ws; const bf16_t* YH = (const bf16_t*)(ws + WS_HB); const float* ssq = (const float*)(ws + WS_SSQ); const float* MOD = (const float*)(ws + WS_MOD);
    const float* npre = p.in[4]; const float* npost = p.in[5];
    const int gw = blockIdx.x * NWAVES + wave, NGW = gridDim.x * NWAVES;
    for (int m = gw; m < M; m += NGW) {
        const int b = m >> 12; f32x4 x[4];
#pragma unroll
        for (int j = 0; j < 4; ++j) x[j] = *(const f32x4*)(xin + (size_t)m * D + 4 * lane + 256 * j);
        if (MODE != 0) {
            float sq = lane < 16 ? ssq[(size_t)m * 16 + lane] : 0.f; sq = wave_sum(sq);
            const float ry = __builtin_amdgcn_rsqf(sq * (1.f / D) + EPS);
#pragma unroll
            for (int j = 0; j < 4; ++j) { const int c = 4 * lane + 256 * j;
                const u32x2 yw = *(const u32x2*)(YH + (size_t)m * D + c);
                const f32x4 g = *(const f32x4*)(MOD + b * 9216 + cur * 3072 + 2048 + c), gp = *(const f32x4*)(npost + cur * 1024 + c);
                x[j][0] += resw * g[0] * (bflo(yw.x) * ry * gp[0]); x[j][1] += resw * g[1] * (bfhi(yw.x) * ry * gp[1]);
                x[j][2] += resw * g[2] * (bflo(yw.y) * ry * gp[2]); x[j][3] += resw * g[3] * (bfhi(yw.y) * ry * gp[3]);
                *(f32x4*)(xout + (size_t)m * D + c) = x[j]; }
        }
        if (MODE != 2) {
            float s2 = 0.f;
#pragma unroll
            for (int j = 0; j < 4; ++j) s2 += (x[j][0] * x[j][0] + x[j][1] * x[j][1]) + (x[j][2] * x[j][2] + x[j][3] * x[j][3]);
            s2 = wave_sum(s2); const float rx = __builtin_amdgcn_rsqf(s2 * (1.f / D) + EPS);
#pragma unroll
            for (int j = 0; j < 4; ++j) { const int c = 4 * lane + 256 * j;
                const f32x4 gp = *(const f32x4*)(npre + nxt * 1024 + c), sc = *(const f32x4*)(MOD + b * 9216 + nxt * 3072 + 1024 + c), sh = *(const f32x4*)(MOD + b * 9216 + nxt * 3072 + c);
                float h[4];
#pragma unroll
                for (int e = 0; e < 4; ++e) h[e] = x[j][e] * rx * gp[e] * (1.f + sc[e]) + sh[e];
                u32x2 w; w.x = pk2(h[0], h[1]); w.y = pk2(h[2], h[3]); *(u32x2*)(HO + (size_t)m * D + c) = w; }
        }
    }
}
#define MFMA32(a, b, c) __builtin_amdgcn_mfma_f32_32x32x16_bf16((a), (b), (c), 0, 0, 0)
__device__ __forceinline__ void attn_phase(const Params& p, LAS unsigned char* lds, int tid, int wave, int lane) {
    unsigned char* ws = p.ws;
    const bf16_t* Qb = (const bf16_t*)(ws + WS_Q); const bf16_t* Kb = (const bf16_t*)(ws + WS_K); const bf16_t* Vt = (const bf16_t*)(ws + WS_VT); bf16_t* Ob = (bf16_t*)(ws + WS_HB);
    LAS float* BT = (LAS float*)lds; const float* bias2 = (const float*)(ws + WS_BIAS);
    for (int i = tid; i < 8 * 257; i += NTHREADS) BT[i] = bias2[i];
    __syncthreads();
    const int r32 = lane & 31, hi = lane >> 5, h = wave;
    const LAS float* BTh = BT + h * 257;
    const float cfar = BTh[256];
    for (int unit = blockIdx.x; unit < 256; unit += gridDim.x) {
        const int b = unit >> 6, n = unit & 63;
        for (int qb = 0; qb < 2; ++qb) {
            const int q = qb * 32 + r32; const size_t rowq = (size_t)b * SEQ + n * 64 + q;
            bf16x8 qf[4];
#pragma unroll
            for (int d0 = 0; d0 < 4; ++d0) qf[d0] = *(const bf16x8*)(Qb + rowq * 512 + h * 64 + d0 * 16 + hi * 8);
            f32x16 o0, o1;
#pragma unroll
            for (int r = 0; r < 16; ++r) { o0[r] = 0.f; o1[r] = 0.f; }
            float mrun = -1e30f, lrun = 0.f;
            const int jlo = n >= 8 ? 0 : 8 - n;
            for (int j = jlo; j <= 8; ++j) {
                const int kc = n - 8 + j; const size_t krow0 = (size_t)b * SEQ + kc * 64;
                f32x16 s0, s1;
#pragma unroll
                for (int r = 0; r < 16; ++r) { s0[r] = 0.f; s1[r] = 0.f; }
                const bf16_t* kp = Kb + (krow0 + r32) * 512 + h * 64 + hi * 8;
                bf16x8 k0[4], k1[4];
#pragma unroll
                for (int d0 = 0; d0 < 4; ++d0) { k0[d0] = *(const bf16x8*)(kp + d0 * 16); k1[d0] = *(const bf16x8*)(kp + 32 * 512 + d0 * 16); }
                const bf16_t* vp = Vt + (((size_t)(b * 512 + h * 64 + r32)) << 12) + kc * 64 + 4 * hi;
                bf16x8 vf[2][2][2];
#pragma unroll
                for (int db = 0; db < 2; ++db)
#pragma unroll
                    for (int kb = 0; kb < 2; ++kb)
#pragma unroll
                        for (int sp = 0; sp < 2; ++sp) { const bf16_t* a = vp + ((size_t)(db * 32) << 12) + kb * 32 + sp * 16; const u32x2 lo = *(const u32x2*)a, hh = *(const u32x2*)(a + 8);
                            const u32x4 w = (u32x4){lo.x, lo.y, hh.x, hh.y}; vf[db][kb][sp] = __builtin_bit_cast(bf16x8, w); }
#pragma unroll
                for (int d0 = 0; d0 < 4; ++d0) { s0 = MFMA32(k0[d0], qf[d0], s0); s1 = MFMA32(k1[d0], qf[d0], s1); }
                if (j <= 5) {
#pragma unroll
                    for (int r = 0; r < 16; ++r) { s0[r] += cfar; s1[r] += cfar; }
                } else {
                    const int base = q + 64 * (8 - j) - 4 * hi + 128;
#pragma unroll
                    for (int r = 0; r < 16; ++r) { const int kv = (r & 3) + 8 * (r >> 2); int i0 = base - kv, i1 = base - kv - 32;
                        i0 = i0 < 0 ? 0 : (i0 > 256 ? 256 : i0); i1 = i1 < 0 ? 0 : (i1 > 256 ? 256 : i1); s0[r] += BTh[i0]; s1[r] += BTh[i1]; }
                }
                float mx = fmaxf(s0[0], s1[0]);
#pragma unroll
                for (int r = 1; r < 16; ++r) mx = fmaxf(mx, fmaxf(s0[r], s1[r]));
                mx = fmaxf(mx, __shfl_xor(mx, 32));
                const float mnew = fmaxf(mrun, mx), alpha = __builtin_amdgcn_exp2f(mrun - mnew); mrun = mnew;
                float rs = 0.f;
#pragma unroll
                for (int r = 0; r < 16; ++r) { s0[r] = __builtin_amdgcn_exp2f(s0[r] - mnew); s1[r] = __builtin_amdgcn_exp2f(s1[r] - mnew); rs += s0[r] + s1[r]; }
                lrun = lrun * alpha + rs;
#pragma unroll
                for (int r = 0; r < 16; ++r) { o0[r] *= alpha; o1[r] *= alpha; }
                bf16x8 pf[2][2];
#pragma unroll
                for (int sp = 0; sp < 2; ++sp) {
                    u32x4 w0, w1;
                    w0.x = pk2(s0[8 * sp + 0], s0[8 * sp + 1]); w0.y = pk2(s0[8 * sp + 2], s0[8 * sp + 3]); w0.z = pk2(s0[8 * sp + 4], s0[8 * sp + 5]); w0.w = pk2(s0[8 * sp + 6], s0[8 * sp + 7]);
                    w1.x = pk2(s1[8 * sp + 0], s1[8 * sp + 1]); w1.y = pk2(s1[8 * sp + 2], s1[8 * sp + 3]); w1.z = pk2(s1[8 * sp + 4], s1[8 * sp + 5]); w1.w = pk2(s1[8 * sp + 6], s1[8 * sp + 7]);
                    pf[0][sp] = __builtin_bit_cast(bf16x8, w0); pf[1][sp] = __builtin_bit_cast(bf16x8, w1);
                }
#pragma unroll
                for (int kb = 0; kb < 2; ++kb)
#pragma unroll
                    for (int sp = 0; sp < 2; ++sp) { o0 = MFMA32(vf[0][kb][sp], pf[kb][sp], o0); o1 = MFMA32(vf[1][kb][sp], pf[kb][sp], o1); }
            }
            lrun += __shfl_xor(lrun, 32); const float inv = 1.f / lrun;
            bf16_t* op = Ob + rowq * 512 + h * 64 + 4 * hi;
#pragma unroll
            for (int g = 0; g < 4; ++g) {
                u32x2 w; w.x = pk2(o0[4 * g] * inv, o0[4 * g + 1] * inv); w.y = pk2(o0[4 * g + 2] * inv, o0[4 * g + 3] * inv); *(u32x2*)(op + 8 * g) = w;
                u32x2 v; v.x = pk2(o1[4 * g] * inv, o1[4 * g + 1] * inv); v.y = pk2(o1[4 * g + 2] * inv, o1[4 * g + 3] * inv); *(u32x2*)(op + 32 + 8 * g) = v;
            }
        }
    }
}

template <bool PASS2> __device__ __forceinline__ void scan_phase(const Params& p, LAS unsigned char* lds, bf16_t* GYO, int wave, int lane) {
    unsigned char* ws = p.ws;
    const bf16_t* XR = (const bf16_t*)(ws + WS_XR); bf16_t* GY = (bf16_t*)(ws + WS_GY);
    const bf16_t* WAt = (const bf16_t*)(ws + WS_LRUWA); const bf16_t* WXt = (const bf16_t*)(ws + WS_LRUWX);
    float* SUMA = (float*)(ws + WS_SUMA); float* SUMH = (float*)(ws + WS_SUMH);
    const float *conv_w = p.in[10], *conv_b = p.in[11], *lba = p.in[13], *lbx = p.in[15], *lam = p.in[16];
    constexpr int XP = 72;
    LAS bf16_t* XT = (LAS bf16_t*)(lds + 16384 + wave * 9728);
    LAS float* CAR = (LAS float*)(lds + 8192);
    const int r32 = lane & 31, hi = lane >> 5;
    for (int unit = blockIdx.x; unit < 256; unit += gridDim.x) {
        const int b = unit >> 6, n = unit & 63;
        if (PASS2) {
            __syncthreads();
            const int tid = wave * 64 + lane;
#pragma unroll
            for (int cc = 0; cc < 2; ++cc) { const int ch = tid + 512 * cc; const float* sa = SUMA + (size_t)(b * 64) * 1024 + ch; const float* sh = SUMH + (size_t)(b * 64) * 1024 + ch;
                float carry = 0.f; int k = 0;
                for (; k + 8 <= n; k += 8) { float av[8], hv[8];
#pragma unroll
                    for (int i = 0; i < 8; ++i) { av[i] = sa[(size_t)(k + i) * 1024]; hv[i] = sh[(size_t)(k + i) * 1024]; }
#pragma unroll
                    for (int i = 0; i < 8; ++i) carry = av[i] * carry + hv[i]; }
                for (; k < n; ++k) carry = sa[(size_t)k * 1024] * carry + sh[(size_t)k * 1024];
                CAR[ch] = carry; }
            __syncthreads();
        }
        for (int bi = 0; bi < 2; ++bi) {
            const int blk = wave + 8 * bi, c0 = blk * 64;
            LDS_WAIT();
#pragma unroll
            for (int it = 0; it < 9; ++it) { const int row = it * 8 + (lane >> 3), ch = (lane & 7) * 8;
                if (row < 67) { const int tpos = n * 64 - 3 + row; u32x4 v = (u32x4){0u, 0u, 0u, 0u};
                    if (tpos >= 0) v = *(const u32x4*)(XR + ((size_t)b * SEQ + tpos) * 1024 + c0 + ch);
                    *(LAS u32x4*)(XT + row * XP + ch) = v; } }
            LDS_WAIT();
            { const int c = c0 + lane; const float w0 = conv_w[c], w1 = conv_w[1024 + c], w2 = conv_w[2048 + c], w3 = conv_w[3072 + c], cb = conv_b[c];
              float x0 = bf2f(XT[0 * XP + lane]), x1 = bf2f(XT[1 * XP + lane]), x2 = bf2f(XT[2 * XP + lane]);
#pragma unroll 8
              for (int t = 0; t < 64; ++t) { const float x3 = bf2f(XT[(t + 3) * XP + lane]); const float xc = cb + w0 * x0 + w1 * x1 + w2 * x2 + w3 * x3; XT[(t + 3) * XP + lane] = f2bf(xc); x0 = x1; x1 = x2; x2 = x3; } }
            LDS_WAIT();
            for (int jb = 0; jb < 2; ++jb) {
                const int j = jb * 32 + r32, ch = c0 + j;
                bf16x8 wa[4], wx[4];
#pragma unroll
                for (int ks = 0; ks < 4; ++ks) { wa[ks] = *(const bf16x8*)(WAt + blk * 4096 + j * 64 + ks * 16 + hi * 8); wx[ks] = *(const bf16x8*)(WXt + blk * 4096 + j * 64 + ks * 16 + hi * 8); }
                float carry = 0.f;
                if (PASS2) carry = CAR[ch];
                f32x16 aa[2], ax[2];
#pragma unroll
                for (int tb = 0; tb < 2; ++tb) {
#pragma unroll
                    for (int r = 0; r < 16; ++r) { aa[tb][r] = 0.f; ax[tb][r] = 0.f; }
#pragma unroll
                    for (int ks = 0; ks < 4; ++ks) { const bf16x8 xa = *(const LAS bf16x8*)(XT + (3 + tb * 32 + r32) * XP + ks * 16 + hi * 8); aa[tb] = MFMA32(xa, wa[ks], aa[tb]); ax[tb] = MFMA32(xa, wx[ks], ax[tb]); }
                }
                const float ba = lba[ch], bx = lbx[ch], sp8 = 8.f * log1pf(__expf(-lam[ch]));
#pragma unroll
                for (int tb = 0; tb < 2; ++tb)
#pragma unroll
                    for (int r = 0; r < 16; ++r) { const int t = tb * 32 + crow(r, hi); const float xcv = bf2f(XT[(3 + t) * XP + j]);
                        const float ra = fsig(aa[tb][r] + ba), ix = fsig(ax[tb][r] + bx), la = -sp8 * ra, a = __expf(la), x2 = 2.f * la, mult = __builtin_amdgcn_sqrtf(-x2 * (1.f + x2 * (0.5f + x2 * (0.16666667f + x2 * (0.041666668f + x2 * (0.0083333338f + x2 * 0.0013888889f))))));
                        aa[tb][r] = a; ax[tb][r] = mult * ix * xcv; }
                float cin[2][4]; float c = carry, ap = 1.f;
#pragma unroll
                for (int tb = 0; tb < 2; ++tb)
#pragma unroll
                    for (int q4 = 0; q4 < 4; ++q4) {
                        const float a0 = aa[tb][4 * q4], a1 = aa[tb][4 * q4 + 1], a2 = aa[tb][4 * q4 + 2], a3 = aa[tb][4 * q4 + 3];
                        const float u0 = ax[tb][4 * q4], u1 = ax[tb][4 * q4 + 1], u2 = ax[tb][4 * q4 + 2], u3 = ax[tb][4 * q4 + 3];
                        const float As = a0 * a1 * a2 * a3, Hs = ((u0 * a1 + u1) * a2 + u2) * a3 + u3;
                        ap *= As;
                        float out = As * c + Hs; const float t1 = __shfl_xor(out, 32);
                        const float ci = hi ? t1 : c; out = As * ci + Hs; const float t2 = __shfl_xor(out, 32);
                        cin[tb][q4] = ci; c = hi ? out : t2;
                    }
                if (!PASS2) {
                    ap *= __shfl_xor(ap, 32);
                    if (hi == 0) { SUMA[(size_t)(b * 64 + n) * 1024 + ch] = ap; SUMH[(size_t)(b * 64 + n) * 1024 + ch] = c; }
                } else {
#pragma unroll
                    for (int tb = 0; tb < 2; ++tb)
#pragma unroll
                        for (int q4 = 0; q4 < 4; ++q4) { float hp = cin[tb][q4];
#pragma unroll
                            for (int e = 0; e < 4; ++e) { const int r = 4 * q4 + e; hp = aa[tb][r] * hp + ax[tb][r];
                                const size_t off = ((size_t)b * SEQ + n * 64 + tb * 32 + 8 * q4 + 4 * hi + e) * 1024 + ch; GYO[off] = f2bf(hp * bf2f(GY[off])); } }
                }
            }
        }
    }
}

#define XB_TMO      128
#define XB_XCNT(j)  (256  + 64 * (j))
#define XB_XSUB(j)  (1280 + 64 * (j))
#define XB_XGEN(j)  (2304 + 64 * (j))
#define XB_TOP      3328
#define XB_TOPGEN   3392
#define XCD_BAR_WORDS 3456
#define XB_SPIN_CAP (1u << 18)

__device__ __forceinline__ unsigned xb_ld(unsigned* p)              { return __hip_atomic_load(p, __ATOMIC_RELAXED, __HIP_MEMORY_SCOPE_AGENT); }
__device__ __forceinline__ unsigned xb_add(unsigned* p, unsigned v) { return __hip_atomic_fetch_add(p, v, __ATOMIC_RELAXED, __HIP_MEMORY_SCOPE_AGENT); }
__device__ __forceinline__ unsigned xb_xcc_id() { return (unsigned)__builtin_amdgcn_s_getreg((3 << 11) | 20) & 0xFu; }
#define XB_SPIN(cond, bar) do { unsigned _sp = 0; while (cond) { __builtin_amdgcn_s_sleep(1); \
    if ((++_sp & 255u) == 0u) { if (xb_ld(&(bar)[XB_TMO])) break; if (_sp > XB_SPIN_CAP) { atomicAdd(&(bar)[XB_TMO], 1u); break; } } } } while (0)

struct XcdBarrier {
    unsigned* bar; unsigned x;
    volatile LAS unsigned* st;
};

__device__ __forceinline__ XcdBarrier xcd_barrier_post(unsigned* bar, volatile LAS unsigned* st) {
    XcdBarrier b; b.bar = bar; b.x = xb_xcc_id(); b.st = st;
    if (threadIdx.x == 0) (void)xb_add(&bar[XB_XCNT(b.x)], 1u);
    return b;
}
__device__ __forceinline__ void xcd_barrier_complete(unsigned* bar, unsigned x, unsigned& nloc, unsigned& nx) {
    const unsigned G = gridDim.x * gridDim.y * gridDim.z;
    unsigned sum, cnt, mine, sp = 0u;
    for (;;) {
        sum = 0u; cnt = 0u; mine = 0u;
#pragma unroll
        for (unsigned j = 0; j < 16; ++j) { const unsigned c = xb_ld(&bar[XB_XCNT(j)]); sum += c; cnt += (c > 0u) ? 1u : 0u; mine = (j == x) ? c : mine; }
        if (sum == G) break;
        __builtin_amdgcn_s_sleep(1);
        if ((++sp & 255u) == 0u) { if (xb_ld(&bar[XB_TMO])) break; if (sp > XB_SPIN_CAP) { atomicAdd(&bar[XB_TMO], 1u); break; } }
    }
    nloc = mine > 0u ? mine : 1u; nx = cnt > 0u ? cnt : 1u;
}

__device__ __forceinline__ void xcd_barrier(const XcdBarrier& b) {
    asm volatile("s_waitcnt vmcnt(0)" ::: "memory");
    __syncthreads();
    if (threadIdx.x == 0) {
        unsigned* bar = b.bar;
        __builtin_amdgcn_s_waitcnt(0);
        unsigned nloc = b.st[0], nx = b.st[1];
        if (nloc == 0u) { xcd_barrier_complete(bar, b.x, nloc, nx); b.st[0] = nloc; b.st[1] = nx; }
        const unsigned old = xb_add(&bar[XB_XSUB(b.x)], 1u);
        const unsigned gen = old / nloc;
        if (old + 1u == (gen + 1u) * nloc) {
            __builtin_amdgcn_fence(__ATOMIC_RELEASE, "agent");
            asm volatile("s_waitcnt vmcnt(0)" ::: "memory");
            const unsigned og = xb_add(&bar[XB_TOP], 1u);
            const unsigned tg = og / nx;
            if (og + 1u == (tg + 1u) * nx) xb_add(&bar[XB_TOPGEN], 1u);
            else XB_SPIN(xb_ld(&bar[XB_TOPGEN]) == tg, bar);
            __builtin_amdgcn_fence(__ATOMIC_ACQUIRE, "agent");
            xb_add(&bar[XB_XGEN(b.x)], 1u);
            asm volatile("s_waitcnt vmcnt(0)" ::: "memory");
        } else {
            XB_SPIN(xb_ld(&bar[XB_XGEN(b.x)]) == gen, bar);
            __builtin_amdgcn_fence(__ATOMIC_ACQUIRE, "agent");
            asm volatile("s_waitcnt vmcnt(0)" ::: "memory");
        }
    }
    __syncthreads();
}

__global__ void __launch_bounds__(NTHREADS, 2) mk_fwd(Params p) {
    extern __shared__ __attribute__((aligned(16))) unsigned char lds_raw[];
    LAS unsigned char* lds = (LAS unsigned char*)lds_raw;
    cg::grid_group grid = cg::this_grid();
    const int tid = threadIdx.x, lane = tid & 63, wave = __builtin_amdgcn_readfirstlane(tid >> 6);
    unsigned char* ws = p.ws;
    const int lo = p.ph_lo, hi_ = p.ph_hi;
#define IN(k) (lo <= (k) && (k) < hi_)
#define SEAM(k) do { if (IN((k) + 1)) xcd_barrier(bar); } while (0)
    volatile LAS unsigned* bst = (volatile LAS unsigned*)(lds + 131072);
    if (tid < 2) bst[tid] = 0u;
    __syncthreads();
    XcdBarrier bar; bar.bar = (unsigned*)(ws + WS_BAR); bar.x = 0; bar.st = bst;
    if (hi_ - lo > 1) bar = xcd_barrier_post((unsigned*)(ws + WS_BAR), bst);
    if (lo < 0) grid.sync();
    bf16_t* HB = (bf16_t*)(ws + WS_HB); bf16_t* ACT = (bf16_t*)(ws + WS_ACT); float* SSQ = (float*)(ws + WS_SSQ);
    const int G = gridDim.x, bx = blockIdx.x; const int dry = p.dry;
    float* XO = dry == 1 ? (float*)(ws + WS_Z) : p.out; bf16_t* HO = dry == 1 ? (bf16_t*)(ws + WS_Z + 64 * MiB) : HB; bf16_t* DZ = (bf16_t*)(ws + WS_Z);
    if (hi_ - lo > 1) for (int i = 0; i < dry; ++i) xcd_barrier(bar);
    if (IN(0)) { p0_prologue(p, lds, tid, wave, lane); SEAM(0); }
    if (IN(1)) { row_phase<0>(p, 0, 0, 0.f, p.in[0], nullptr, HB, wave, lane); SEAM(1); }
    if (IN(2)) { pg8::Gemm g{HB, (const bf16_t*)(ws + WS_WGU1), M, NPROJ, D}; pg8::StaticOrder S; S.init(M, NPROJ, G, bx); pg8::EpiSwiglu E{ACT, FF};
        pg8::gemm_phase<pg8::EpiSwiglu, pg8::StaticOrder, true, true>(lds, g, S, E); SEAM(2); }
    if (IN(3)) { pg8::Gemm g{ACT, (const bf16_t*)(ws + WS_WD1), M, D, FF}; pg8::StaticOrder S; S.init(M, D, G, bx); pg8::EpiY E{HB, SSQ};
        pg8::gemm_phase<pg8::EpiY, pg8::StaticOrder, true, true>(lds, g, S, E); SEAM(3); }
    if (IN(4)) { row_phase<1>(p, 0, 1, 0.5f, p.in[0], XO, HO, wave, lane); SEAM(4); }
    if (IN(5)) { pg8::Gemm g{HB, (const bf16_t*)(ws + WS_WIN), M, NPROJ, D}; pg8::StaticOrder S; S.init(M, NPROJ, G, bx);
        pg8::EpiProj E{(bf16_t*)(ws + WS_Q), (bf16_t*)(ws + WS_K), (bf16_t*)(ws + WS_VT), (bf16_t*)(ws + WS_XR), (bf16_t*)(ws + WS_GY), (bf16_t*)(ws + WS_SGA), (bf16_t*)(ws + WS_SGR), 0.125f * LOG2E};
        pg8::gemm_phase<pg8::EpiProj, pg8::StaticOrder, true, true>(lds, g, S, E); SEAM(5); }
    if (IN(6)) { if (dry != 3) attn_phase(p, lds, tid, wave, lane); if (dry != 2) scan_phase<false>(p, lds, nullptr, wave, lane); SEAM(6); }
    if (IN(7)) { scan_phase<true>(p, lds, dry == 1 ? DZ : (bf16_t*)(ws + WS_GY), wave, lane); __syncthreads();
        pg8::Gemm g{(const bf16_t*)(ws + WS_HB), (const bf16_t*)(ws + WS_WAO), M, D, 512}; pg8::StaticOrder S; S.init(M, D, G, bx); pg8::EpiGate<false> E{(const bf16_t*)(ws + WS_SGA), (const bf16_t*)(ws + WS_SGA), dry == 1 ? DZ : (bf16_t*)(ws + WS_SGA)};
        pg8::gemm_phase<pg8::EpiGate<false>, pg8::StaticOrder, true, true>(lds, g, S, E); SEAM(7); }
    if (IN(8)) { pg8::Gemm g{(const bf16_t*)(ws + WS_GY), (const bf16_t*)(ws + WS_WRO), M, D, D}; pg8::StaticOrder S; S.init(M, D, G, bx); pg8::EpiGate<true> E{(const bf16_t*)(ws + WS_SGR), (const bf16_t*)(ws + WS_SGA), dry == 1 ? DZ : (bf16_t*)(ws + WS_SGA)};
        pg8::gemm_phase<pg8::EpiGate<true>, pg8::StaticOrder, true, true>(lds, g, S, E); SEAM(8); }
    if (IN(9)) { pg8::Gemm g{(const bf16_t*)(ws + WS_SGA), (const bf16_t*)(ws + WS_WOUT), M, D, D}; pg8::StaticOrder S; S.init(M, D, G, bx); pg8::EpiY E{HB, SSQ};
        pg8::gemm_phase<pg8::EpiY, pg8::StaticOrder, true, true>(lds, g, S, E); SEAM(9); }
    if (IN(10)) { row_phase<1>(p, 1, 2, 1.0f, p.out, XO, HO, wave, lane); SEAM(10); }
    if (IN(11)) { pg8::Gemm g{HB, (const bf16_t*)(ws + WS_WGU2), M, NPROJ, D}; pg8::StaticOrder S; S.init(M, NPROJ, G, bx); pg8::EpiSwiglu E{ACT, FF};
        pg8::gemm_phase<pg8::EpiSwiglu, pg8::StaticOrder, true, true>(lds, g, S, E); SEAM(11); }
    if (IN(12)) { pg8::Gemm g{ACT, (const bf16_t*)(ws + WS_WD2), M, D, FF}; pg8::StaticOrder S; S.init(M, D, G, bx); pg8::EpiY E{HB, SSQ};
        pg8::gemm_phase<pg8::EpiY, pg8::StaticOrder, true, true>(lds, g, S, E); SEAM(12); }
    if (IN(13)) { row_phase<2>(p, 2, 2, 0.5f, p.out, XO, HO, wave, lane); }
#undef IN
#undef SEAM
}

extern "C" void kernel_launch(void* const* d_in, const int* in_sizes, int n_in, void* d_out, int out_size, void* d_ws, size_t ws_size, hipStream_t stream) {
    static int grid = 0;
    if (grid == 0) {
        int dev = 0, cus = 0, per_cu = 0;
        (void)hipGetDevice(&dev); (void)hipDeviceGetAttribute(&cus, hipDeviceAttributeMultiprocessorCount, dev);
        (void)hipFuncSetAttribute((const void*)mk_fwd, hipFuncAttributeMaxDynamicSharedMemorySize, LDS_BYTES);
        (void)hipOccupancyMaxActiveBlocksPerMultiprocessor(&per_cu, (const void*)mk_fwd, NTHREADS, LDS_BYTES);
        if (per_cu < 1) { fprintf(stderr, "kernel_launch: occupancy query says %d blocks/CU\n", per_cu); per_cu = 1; }
        (void)hipGetLastError();
        grid = cus * per_cu;
        if (n_in != 22 || ws_size < WS_END) { fprintf(stderr, "kernel_launch: unexpected n_in %d / ws %zu\n", n_in, ws_size); }
    }
    Params p{};
    for (int i = 0; i < 22; ++i) p.in[i] = (const float*)d_in[i];
    p.out = (float*)d_out; p.ws = (unsigned char*)d_ws;
#if MK_MULTI
    static const int seq[] = {MK_SEQ};
    for (int k0 : seq) { const int k = k0 % 100; p.dry = k0 / 100; p.ph_lo = k; p.ph_hi = k + 1; hipLaunchKernelGGL(mk_fwd, dim3(grid), dim3(NTHREADS), LDS_BYTES, stream, p); }
#else
    p.ph_lo = 0; p.ph_hi = N_PHASES; p.dry = MK_XSYNC;
    (void)hipMemsetAsync((unsigned char*)d_ws + WS_BAR, 0, BAR_BYTES, stream);
    void* args[] = {&p};
    hipError_t e = hipLaunchCooperativeKernel((const void*)mk_fwd, dim3(grid), dim3(NTHREADS), args, LDS_BYTES, stream);
    if (e != hipSuccess) fprintf(stderr, "cooperative launch failed: %s (grid %d)\n", hipGetErrorString(e), grid);
#endif
}
```
